# Optimizing an MI355X kernel written in HIP

```python
import math
import jax, jax.numpy as jnp
from jax import lax
import numpy as np

D_MODEL = 1024
BATCH = 4
SEQ = 8192
DEPTH = 1

MOBA_HEADS = 8
MOBA_HEAD_DIM = 64
MOBA_BLOCK = 256
MOBA_TOPK = 3
MLA_HEADS = 8
MLA_Q_RANK = 256
MLA_KV_RANK = 128
MLA_NOPE_DIM = 64
MLA_ROPE_DIM = 32
MLA_V_DIM = 64
ROPE_THETA = 10000.0
REL_BUCKETS = 32
REL_MAX_DIST = 128
D_FF = 2816
CONV_WIDTH = 3
N_BRANCH = 2
Q_BLOCK = 128
EPS = 1e-6

MOBA_WIDTH = MOBA_HEADS * MOBA_HEAD_DIM
MLA_QK_DIM = MLA_NOPE_DIM + MLA_ROPE_DIM
MLA_WIDTH = MLA_HEADS * MLA_V_DIM
IN_COLS = 3 * MOBA_WIDTH + MLA_Q_RANK + MLA_KV_RANK + MLA_ROPE_DIM + N_BRANCH * D_MODEL
IN_SPLITS = [MOBA_WIDTH, 2 * MOBA_WIDTH, 3 * MOBA_WIDTH,
             3 * MOBA_WIDTH + MLA_Q_RANK,
             3 * MOBA_WIDTH + MLA_Q_RANK + MLA_KV_RANK,
             3 * MOBA_WIDTH + MLA_Q_RANK + MLA_KV_RANK + MLA_ROPE_DIM]

kernel_name = "hybrid_moba_mla_gated_convffn"


def rms_norm(x, g):
    x32 = x.astype(jnp.float32)
    y = x32 * lax.rsqrt(jnp.mean(x32 * x32, axis=-1, keepdims=True) + EPS)
    return (y * g.astype(jnp.float32)).astype(x.dtype)


def t5_bucket(rel):
    n = jnp.maximum(rel, 0)
    max_exact = REL_BUCKETS // 2
    nf = jnp.maximum(n, 1).astype(jnp.float32)
    large = max_exact + (jnp.log(nf / max_exact) / math.log(REL_MAX_DIST / max_exact)
                         * (REL_BUCKETS - max_exact)).astype(jnp.int32)
    large = jnp.minimum(large, REL_BUCKETS - 1)
    return jnp.where(n < max_exact, n, large)


def rope_tables(seq, dim, dtype):
    inv_freq = ROPE_THETA ** (-jnp.arange(0, dim, 2, dtype=jnp.float32) / dim)
    ang = jnp.arange(seq, dtype=jnp.float32)[:, None] * inv_freq[None, :]
    return jnp.cos(ang).astype(dtype), jnp.sin(ang).astype(dtype)


def apply_rope(x, cos, sin):
    half = x.shape[-1] // 2
    x1, x2 = x[..., :half], x[..., half:]
    return jnp.concatenate([x1 * cos - x2 * sin, x2 * cos + x1 * sin], axis=-1)


def to_heads(t, n_heads):
    b, s, _ = t.shape
    return t.reshape(b, s, n_heads, -1).transpose(0, 2, 1, 3)


def merge_heads(t):
    b, h, s, d = t.shape
    return t.transpose(0, 2, 1, 3).reshape(b, s, h * d)


def moba_attention(q, k, v, rel_bias):
    b, h, s, dh = q.shape
    nb = -(-s // MOBA_BLOCK)
    pad = nb * MOBA_BLOCK - s
    k_p = jnp.pad(k, ((0, 0), (0, 0), (0, pad), (0, 0)))
    v_p = jnp.pad(v, ((0, 0), (0, 0), (0, pad), (0, 0)))
    k_blocks = k_p.reshape(b, h, nb, MOBA_BLOCK, dh)
    v_blocks = v_p.reshape(b, h, nb, MOBA_BLOCK, dh)
    k_mean = jnp.mean(k_blocks, axis=3)

    pos = jnp.arange(s, dtype=jnp.int32)
    q_blk = pos // MOBA_BLOCK
    gate = jnp.einsum('bhsd,bhnd->bhsn', q, k_mean).astype(jnp.float32)
    past = jnp.arange(nb, dtype=jnp.int32)[None, :] < q_blk[:, None]
    gate = jnp.where(past, gate, -jnp.inf)
    kk = min(MOBA_TOPK, nb)
    _, idx = lax.top_k(gate, kk)

    nc = s // Q_BLOCK
    q_c = q.reshape(b, h, nc, Q_BLOCK, dh).transpose(2, 0, 1, 3, 4)
    idx_c = idx.reshape(b, h, nc, Q_BLOCK, kk).transpose(2, 0, 1, 3, 4)
    bias_h = rel_bias.T
    bi = jnp.arange(b)[:, None, None, None]
    hi = jnp.arange(h)[None, :, None, None]
    offs = jnp.arange(MOBA_BLOCK, dtype=jnp.int32)
    scale = MOBA_HEAD_DIM ** -0.5

    def chunk(args):
        qc, ic, c = args
        q_pos = c * Q_BLOCK + jnp.arange(Q_BLOCK, dtype=jnp.int32)
        qb = (c * Q_BLOCK) // MOBA_BLOCK
        kb = k_blocks[bi, hi, ic]
        vb = v_blocks[bi, hi, ic]
        k_pos_sel = ic[..., None] * MOBA_BLOCK + offs
        rel_sel = q_pos[:, None, None] - k_pos_sel
        s_sel = (jnp.einsum('bhqd,bhqjkd->bhqjk', qc, kb).astype(jnp.float32) * scale
                 + bias_h[hi[..., None], t5_bucket(rel_sel)].astype(jnp.float32))
        s_sel = jnp.where((ic < qb)[..., None], s_sel, -jnp.inf)
        s_sel = s_sel.reshape(b, h, Q_BLOCK, kk * MOBA_BLOCK)
        start = qb * MOBA_BLOCK
        k_own = lax.dynamic_slice_in_dim(k_p, start, MOBA_BLOCK, axis=2)
        v_own = lax.dynamic_slice_in_dim(v_p, start, MOBA_BLOCK, axis=2)
        rel_own = q_pos[:, None] - (start + offs)[None, :]
        s_own = (jnp.einsum('bhqd,bhkd->bhqk', qc, k_own).astype(jnp.float32) * scale
                 + bias_h[:, t5_bucket(rel_own)].astype(jnp.float32))
        s_own = jnp.where(rel_own >= 0, s_own, -jnp.inf)
        p = jax.nn.softmax(jnp.concatenate([s_sel, s_own], axis=-1), axis=-1).astype(v.dtype)
        p_sel = p[..., :kk * MOBA_BLOCK].reshape(b, h, Q_BLOCK, kk, MOBA_BLOCK)
        p_own = p[..., kk * MOBA_BLOCK:]
        return (jnp.einsum('bhqjk,bhqjkd->bhqd', p_sel, vb)
                + jnp.einsum('bhqk,bhkd->bhqd', p_own, v_own))

    out = lax.map(chunk, (q_c, idx_c, jnp.arange(nc, dtype=jnp.int32)))
    return out.transpose(1, 2, 0, 3, 4).reshape(b, h, s, dh)


def mla_attention(q_nope, q_rope, k_nope, k_rope, v):
    b, h, s, _ = q_nope.shape
    nc = s // Q_BLOCK
    qn_c = q_nope.reshape(b, h, nc, Q_BLOCK, -1).transpose(2, 0, 1, 3, 4)
    qr_c = q_rope.reshape(b, h, nc, Q_BLOCK, -1).transpose(2, 0, 1, 3, 4)
    k_pos = jnp.arange(s, dtype=jnp.int32)
    scale = MLA_QK_DIM ** -0.5

    def chunk(args):
        qn, qr, c = args
        q_pos = c * Q_BLOCK + jnp.arange(Q_BLOCK, dtype=jnp.int32)
        sc = (jnp.einsum('bhqd,bhkd->bhqk', qn, k_nope)
              + jnp.einsum('bhqr,bkr->bhqk', qr, k_rope)).astype(jnp.float32) * scale
        sc = jnp.where(k_pos[None, :] <= q_pos[:, None], sc, -jnp.inf)
        p = jax.nn.softmax(sc, axis=-1).astype(v.dtype)
        return jnp.einsum('bhqk,bhkd->bhqd', p, v)

    out = lax.map(chunk, (qn_c, qr_c, jnp.arange(nc, dtype=jnp.int32)))
    return out.transpose(1, 2, 0, 3, 4).reshape(b, h, s, -1)


def causal_dwconv(u, w, bias):
    s = u.shape[1]
    up = jnp.pad(u, ((0, 0), (CONV_WIDTH - 1, 0), (0, 0)))
    y = bias
    for j in range(CONV_WIDTH):
        y = y + w[j] * up[:, j:j + s]
    return y


def setup_inputs(seed: int = 0) -> dict:
    key = jax.random.key(seed)
    ks = jax.random.split(key, 20)

    def nrm(k, shape, scale):
        return jax.random.normal(k, shape, jnp.float32) * scale

    L = DEPTH
    conv_w = nrm(ks[14], (L, CONV_WIDTH, 2 * D_FF), 0.2)
    conv_w = conv_w.at[:, CONV_WIDTH - 1].add(1.0)
    return {
        "x": nrm(ks[0], (BATCH, SEQ, D_MODEL), 1.0),
        "norm_attn_g": 1.0 + nrm(ks[1], (L, D_MODEL), 0.02),
        "w_in": nrm(ks[2], (L, D_MODEL, IN_COLS), D_MODEL ** -0.5),
        "b_gate": nrm(ks[3], (L, N_BRANCH * D_MODEL), 0.1),
        "q_norm_g": 1.0 + nrm(ks[4], (L, MLA_Q_RANK), 0.02),
        "w_uq": nrm(ks[5], (L, MLA_Q_RANK, MLA_HEADS * MLA_QK_DIM), MLA_Q_RANK ** -0.5),
        "kv_norm_g": 1.0 + nrm(ks[6], (L, MLA_KV_RANK), 0.02),
        "w_ukv": nrm(ks[7], (L, MLA_KV_RANK, MLA_HEADS * (MLA_NOPE_DIM + MLA_V_DIM)), MLA_KV_RANK ** -0.5),
        "rel_bias": nrm(ks[8], (REL_BUCKETS, MOBA_HEADS), 0.3),
        "w_branch_moba": nrm(ks[9], (L, MOBA_WIDTH, D_MODEL), MOBA_WIDTH ** -0.5),
        "w_branch_mla": nrm(ks[10], (L, MLA_WIDTH, D_MODEL), MLA_WIDTH ** -0.5),
        "w_out": nrm(ks[11], (L, D_MODEL, D_MODEL), D_MODEL ** -0.5),
        "norm_ffn_g": 1.0 + nrm(ks[12], (L, D_MODEL), 0.02),
        "w_up": nrm(ks[13], (L, D_MODEL, 2 * D_FF), D_MODEL ** -0.5),
        "conv_w": conv_w,
        "conv_b": nrm(ks[15], (L, 2 * D_FF), 0.02),
        "w_down": nrm(ks[16], (L, D_FF, D_MODEL), D_FF ** -0.5),
        "norm_final_g": 1.0 + nrm(ks[17], (D_MODEL,), 0.02),
    }


def reference(x, norm_attn_g, w_in, b_gate, q_norm_g, w_uq, kv_norm_g, w_ukv, rel_bias,
              w_branch_moba, w_branch_mla, w_out, norm_ffn_g, w_up, conv_w, conv_b, w_down,
              norm_final_g):
    b, s, _ = x.shape
    cos, sin = rope_tables(s, MLA_ROPE_DIM, x.dtype)
    h = x
    for l in range(DEPTH):
        xn = rms_norm(h, norm_attn_g[l])
        proj = xn @ w_in[l]
        q_a, k_a, v_a, c_q, c_kv, k_rope, gates = jnp.split(proj, IN_SPLITS, axis=-1)

        y_a = merge_heads(moba_attention(to_heads(q_a, MOBA_HEADS), to_heads(k_a, MOBA_HEADS),
                                         to_heads(v_a, MOBA_HEADS), rel_bias))

        q = (rms_norm(c_q, q_norm_g[l]) @ w_uq[l]).reshape(b, s, MLA_HEADS, MLA_QK_DIM)
        q_nope = q[..., :MLA_NOPE_DIM]
        q_rope = apply_rope(q[..., MLA_NOPE_DIM:], cos[:, None, :], sin[:, None, :])
        kv = (rms_norm(c_kv, kv_norm_g[l]) @ w_ukv[l]).reshape(b, s, MLA_HEADS, MLA_NOPE_DIM + MLA_V_DIM)
        k_nope = kv[..., :MLA_NOPE_DIM]
        v_b = kv[..., MLA_NOPE_DIM:]
        k_r = apply_rope(k_rope, cos, sin)
        y_b = merge_heads(mla_attention(q_nope.transpose(0, 2, 1, 3), q_rope.transpose(0, 2, 1, 3),
                                        k_nope.transpose(0, 2, 1, 3), k_r,
                                        v_b.transpose(0, 2, 1, 3)))

        g = jax.nn.sigmoid(gates + b_gate[l]).reshape(b, s, N_BRANCH, D_MODEL)
        mixed = g[..., 0, :] * (y_a @ w_branch_moba[l]) + g[..., 1, :] * (y_b @ w_branch_mla[l])
        h = h + mixed @ w_out[l]

        hn = rms_norm(h, norm_ffn_g[l])
        u = causal_dwconv(hn @ w_up[l], conv_w[l], conv_b[l])
        u_gate, u_val = u[..., :D_FF], u[..., D_FF:]
        h = h + (jax.nn.silu(u_gate) * u_val) @ w_down[l]
    return rms_norm(h, norm_final_g)
```

```cpp
#include <hip/hip_runtime.h>
#include <cstdio>
#include <cstdint>

constexpr int BATCH = 4, SEQ = 8192, DM = 1024, T = BATCH * SEQ;
constexpr int IN_COLS = 4000, NP1 = 4096;
constexpr int DFF = 2816, DFF2 = 5632;
constexpr float EPS = 1e-6f;
constexpr float LOG2E = 1.4426950408889634f;
constexpr float C2_MOBA = 0.125f * LOG2E;
constexpr float C2_MLA = 0.10206207261596577f * LOG2E;

namespace pg8 {
#define PG8_LAS __attribute__((address_space(3)))
typedef unsigned short bf16_t;
typedef short bf16x8 __attribute__((ext_vector_type(8)));
typedef float f32x4 __attribute__((ext_vector_type(4)));
typedef unsigned u32x4 __attribute__((ext_vector_type(4)));
constexpr int BM = 256, BK = 64, HALF = 128, HTB = HALF * BK * 2  , STAGE_BYTES = 8 * HTB, NXCD = 8, WGM = 8;

__host__ __device__ __forceinline__ int lds_byte(int r, int c) { const int st = (r >> 4) * 2 + (c >> 5), rr = r & 15, cc = c & 31, ob = rr * 64 + cc * 2; return st * 1024 + (ob ^ (((ob >> 9) & 1) << 5)); }
__host__ __device__ __forceinline__ void stage_rc(int b, int& R, int& C) { const int st = b / 1024, sb = b % 1024, swz = sb ^ (((sb >> 9) & 1) << 5); R = (st >> 1) * 16 + swz / 64; C = (st & 1) * 32 + (swz % 64) / 2; }
__host__ __device__ __forceinline__ int perm32(int rho) { const int n = rho >> 4, i = rho & 15; return 8 * (i >> 2) + 4 * n + (i & 3); }

struct Unit { int pm, pn, z; };
struct Gemm { const bf16_t* A0; long dA; const bf16_t* B0; long dB; int lda, K; };

struct StaticOrder {
    int nM, nN, nwg, G, c, zrep;
    __host__ __device__ void init(int M, int N, int G_, int c_, int zrep_ = 1) { nM = M / BM; nN = N / BM; nwg = nM * nN; G = G_; c = c_; zrep = zrep_; }
    __host__ __device__ bool next(int ii, Unit& u) const {
        const int i = ii / zrep; u.z = ii % zrep;
        const long L = (long)i * G + c; if (L >= nwg) return false;
        int wgid = (int)L; { const int q = nwg / NXCD, r = nwg % NXCD, xcd = wgid % NXCD, off = wgid / NXCD; wgid = (xcd < r ? xcd * (q + 1) : r * (q + 1) + (xcd - r) * q) + off; }
        const int nig = WGM * nN, gid = wgid / nig, fm = gid * WGM, gsz = (nM - fm) < WGM ? (nM - fm) : WGM;
        u.pm = fm + ((wgid % nig) % gsz); u.pn = (wgid % nig) / gsz; return true;
    }
};

typedef float f32x2_t __attribute__((ext_vector_type(2))); typedef __bf16 bf16x2_t __attribute__((ext_vector_type(2)));
__device__ __forceinline__ unsigned cvt_pk_bf16(float lo, float hi) { f32x2_t v = {lo, hi}; bf16x2_t b = __builtin_convertvector(v, bf16x2_t); return __builtin_bit_cast(unsigned, b); }
__device__ __forceinline__ u32x4 pack8(f32x4 v0, f32x4 v1) { u32x4 w; w.x = cvt_pk_bf16(v0[0], v0[1]); w.y = cvt_pk_bf16(v0[2], v0[3]); w.z = cvt_pk_bf16(v1[0], v1[1]); w.w = cvt_pk_bf16(v1[2], v1[3]); return w; }
__device__ __forceinline__ float bf2f(unsigned short h) { return __uint_as_float((unsigned)h << 16); }
__device__ __forceinline__ void unpack8(u32x4 w, f32x4& a, f32x4& b) {
    a[0] = __uint_as_float(w.x << 16); a[1] = __uint_as_float(w.x & 0xffff0000u); a[2] = __uint_as_float(w.y << 16); a[3] = __uint_as_float(w.y & 0xffff0000u);
    b[0] = __uint_as_float(w.z << 16); b[1] = __uint_as_float(w.z & 0xffff0000u); b[2] = __uint_as_float(w.w << 16); b[3] = __uint_as_float(w.w & 0xffff0000u);
}

template <class Epi, class Sched, bool ALIGN_EPI = false, bool SP2 = false>
__device__ __forceinline__ void gemm_phase(PG8_LAS unsigned char* lds, const Gemm g, const Sched& S, const Epi& E) {
    int tid_ = threadIdx.x; asm volatile("" : "+v"(tid_));
    const int tid = tid_, wid = __builtin_amdgcn_readfirstlane(tid >> 6), lane = tid & 63, wr = wid >> 2, wc = wid & 3, fr = lane & 15, fq = lane >> 4;
    const int K = g.K, nt = K / BK, lda = g.lda;
    unsigned voffA[2], voffB[2];
#pragma unroll
    for (int i = 0; i < 2; ++i) { int R, C; stage_rc(tid * 16 + i * 8192, R, C); const int Rb = (R & ~31) + perm32(R & 31);
        voffA[i] = (unsigned)(R * lda + C) * 2u; voffB[i] = (unsigned)(Rb * K + C) * 2u; }
    const size_t kstep = (size_t)(BK * 2);
    const size_t hstepA = (size_t)HALF * lda * 2, hstepB = (size_t)HALF * K * 2;
    const size_t tstepA = 2 * hstepA, tstepB = 2 * hstepB;
    const unsigned ldsw = (unsigned)wid * 1024u;
    const int aoff = lds_byte(wr * 64 + fr, fq * 8), boff = lds_byte(wc * 32 + fr, fq * 8);
#define PG8_SA(b, h) (((b) * 2 + (h)) * HTB)
#define PG8_SB(b, h) ((4 + (b) * 2 + (h)) * HTB)
#define PG8_STAGE(bufoff, gbase, voff) do { _Pragma("unroll") for (int _i = 0; _i < 2; ++_i) \
        __builtin_amdgcn_global_load_lds((const unsigned*)((const char*)(gbase) + (voff)[_i]), (PG8_LAS unsigned*)(lds + (bufoff) + ldsw + _i * 8192), 16, 0, 0); } while (0)
#define PG8_LDA(dst, b, h) do { _Pragma("unroll") for (int m = 0; m < 4; ++m) _Pragma("unroll") for (int k = 0; k < 2; ++k) dst[m][k] = *(const PG8_LAS bf16x8*)(lds + PG8_SA(b, h) + aoff + m * 2048 + k * 1024); } while (0)
#define PG8_LDB(dst, b, h) do { _Pragma("unroll") for (int n = 0; n < 2; ++n) _Pragma("unroll") for (int k = 0; k < 2; ++k) dst[n][k] = *(const PG8_LAS bf16x8*)(lds + PG8_SB(b, h) + boff + n * 2048 + k * 1024); } while (0)
#define PG8_MMA(ai, bj, At, Bt) do { __builtin_amdgcn_s_setprio(1); _Pragma("unroll") for (int m = 0; m < 4; ++m) _Pragma("unroll") for (int n = 0; n < 2; ++n) _Pragma("unroll") for (int k = 0; k < 2; ++k) \
        acc[ai][bj][m][n] = __builtin_amdgcn_mfma_f32_16x16x32_bf16(Bt[n][k], At[m][k], acc[ai][bj][m][n], 0, 0, 0); __builtin_amdgcn_s_setprio(0); } while (0)
#define PG8_WAIT_V(n) asm volatile("s_waitcnt vmcnt(" #n ")" ::: "memory")
#define PG8_WAIT_L(n) asm volatile("s_waitcnt lgkmcnt(" #n ")" ::: "memory")
#define PG8_BAR __builtin_amdgcn_s_barrier()
#define PG8_SCHED __builtin_amdgcn_sched_barrier(0)
#define PG8_BASEA(u) ((const char*)(g.A0 + (long)(u).z * g.dA) + (size_t)(u).pm * tstepA)
#define PG8_BASEB(u) ((const char*)(g.B0 + (long)(u).z * g.dB) + (size_t)(u).pn * tstepB)
    Unit cur, nxt; int ui = 0;
    if (!S.next(0, cur)) return;
    f32x4 acc[2][2][4][2];
#pragma unroll
    for (int a = 0; a < 2; ++a)
#pragma unroll
        for (int b = 0; b < 2; ++b)
#pragma unroll
            for (int m = 0; m < 4; ++m)
#pragma unroll
                for (int n = 0; n < 2; ++n) acc[a][b][m][n] = (f32x4){0.f, 0.f, 0.f, 0.f};
    bf16x8 At[4][2], B0[2][2], B1[2][2];
    const char* cA = PG8_BASEA(cur); const char* cB = PG8_BASEB(cur);
    if constexpr (SP2) {
        PG8_STAGE(PG8_SB(0, 0), cB, voffB); PG8_STAGE(PG8_SB(0, 1), cB + hstepB, voffB); PG8_STAGE(PG8_SA(0, 0), cA, voffA); PG8_STAGE(PG8_SA(0, 1), cA + hstepA, voffA);
        if (wr == 1) PG8_BAR;
        PG8_WAIT_V(2); PG8_BAR;
        PG8_STAGE(PG8_SB(1, 0), cB + kstep, voffB); PG8_STAGE(PG8_SA(1, 0), cA + kstep, voffA); PG8_STAGE(PG8_SB(1, 1), cB + hstepB + kstep, voffB);
        PG8_WAIT_V(6); PG8_BAR;
    } else {
        PG8_STAGE(PG8_SB(0, 0), cB, voffB); PG8_STAGE(PG8_SA(0, 0), cA, voffA); PG8_STAGE(PG8_SB(0, 1), cB + hstepB, voffB); PG8_STAGE(PG8_SA(0, 1), cA + hstepA, voffA);
        if (wr == 1) PG8_BAR;
        PG8_WAIT_V(4); PG8_BAR;
        PG8_STAGE(PG8_SB(1, 0), cB + kstep, voffB); PG8_STAGE(PG8_SA(1, 0), cA + kstep, voffA); PG8_STAGE(PG8_SB(1, 1), cB + hstepB + kstep, voffB);
        PG8_WAIT_V(6); PG8_BAR;
    }
    for (;;) {
        const bool has_next = S.next(ui + 1, nxt);
        const char* nA = has_next ? PG8_BASEA(nxt) : cA; const char* nB = has_next ? PG8_BASEB(nxt) : cB;
        for (int t = 0; t < nt; t += 2) {
            const bool last = (t == nt - 2);
            const char* a1 = cA + (size_t)(t + 1) * kstep;
            const char* a2 = last ? nA : cA + (size_t)(t + 2) * kstep; const char* b2 = last ? nB : cB + (size_t)(t + 2) * kstep;
            const char* a3 = a2 + kstep; const char* b3 = b2 + kstep;
            if constexpr (SP2) {
            PG8_LDB(B0, 0, 0); PG8_LDB(B1, 0, 1); PG8_SCHED; PG8_LDA(At, 0, 0); PG8_STAGE(PG8_SA(1, 1), a1 + hstepA, voffA);
            PG8_WAIT_V(8); PG8_WAIT_L(0); PG8_BAR; PG8_MMA(0, 0, At, B0); PG8_MMA(0, 1, At, B1); PG8_BAR; PG8_SCHED;
            PG8_LDA(At, 0, 1); PG8_STAGE(PG8_SB(0, 0), b2, voffB); PG8_STAGE(PG8_SB(0, 1), b2 + hstepB, voffB); PG8_STAGE(PG8_SA(0, 0), a2, voffA);
            PG8_WAIT_V(8); PG8_WAIT_L(0); PG8_BAR; PG8_MMA(1, 0, At, B0); PG8_MMA(1, 1, At, B1); PG8_BAR; PG8_SCHED;
            PG8_LDB(B0, 1, 0); PG8_LDB(B1, 1, 1); PG8_SCHED; PG8_LDA(At, 1, 0); PG8_STAGE(PG8_SA(0, 1), a2 + hstepA, voffA);
            PG8_WAIT_V(8); PG8_WAIT_L(0); PG8_BAR; PG8_MMA(0, 0, At, B0); PG8_MMA(0, 1, At, B1); PG8_BAR; PG8_SCHED;
            PG8_LDA(At, 1, 1); PG8_STAGE(PG8_SB(1, 0), b3, voffB); PG8_STAGE(PG8_SB(1, 1), b3 + hstepB, voffB); PG8_STAGE(PG8_SA(1, 0), a3, voffA);
            PG8_WAIT_V(8); PG8_WAIT_L(0); PG8_BAR; PG8_MMA(1, 0, At, B0); PG8_MMA(1, 1, At, B1); PG8_BAR; PG8_SCHED;
            } else {
            PG8_LDB(B0, 0, 0); PG8_SCHED; PG8_LDA(At, 0, 0); PG8_STAGE(PG8_SA(1, 1), a1 + hstepA, voffA);
            PG8_WAIT_L(8); PG8_BAR; PG8_WAIT_L(0); PG8_MMA(0, 0, At, B0); PG8_BAR; PG8_SCHED;
            PG8_LDB(B1, 0, 1); PG8_STAGE(PG8_SB(0, 0), b2, voffB);
            PG8_BAR; PG8_WAIT_L(0); PG8_MMA(0, 1, At, B1); PG8_BAR;
            PG8_LDA(At, 0, 1); PG8_STAGE(PG8_SA(0, 0), a2, voffA);
            PG8_BAR; PG8_WAIT_L(0); PG8_MMA(1, 0, At, B0); PG8_BAR; PG8_SCHED;
            PG8_STAGE(PG8_SB(0, 1), b2 + hstepB, voffB);
            PG8_WAIT_V(6); PG8_BAR; PG8_MMA(1, 1, At, B1); PG8_BAR;
            PG8_LDB(B0, 1, 0); PG8_SCHED; PG8_LDA(At, 1, 0); PG8_STAGE(PG8_SA(0, 1), a2 + hstepA, voffA);
            PG8_WAIT_L(8); PG8_BAR; PG8_WAIT_L(0); PG8_MMA(0, 0, At, B0); PG8_BAR; PG8_SCHED;
            PG8_LDB(B1, 1, 1); PG8_STAGE(PG8_SB(1, 0), b3, voffB);
            PG8_BAR; PG8_WAIT_L(0); PG8_MMA(0, 1, At, B1); PG8_BAR;
            PG8_LDA(At, 1, 1); PG8_STAGE(PG8_SA(1, 0), a3, voffA);
            PG8_BAR; PG8_WAIT_L(0); PG8_MMA(1, 0, At, B0); PG8_BAR; PG8_SCHED;
            PG8_STAGE(PG8_SB(1, 1), b3 + hstepB, voffB);
            PG8_WAIT_V(6); PG8_BAR; PG8_MMA(1, 1, At, B1); PG8_BAR;
            }
        }
        if constexpr (ALIGN_EPI) { if (wr == 0) PG8_BAR; }
        E(acc, cur, wr, wc, fr, fq);
        if (!has_next) break;
        bool keep_acc = false;
        if constexpr (Epi::HAS_KEEP) keep_acc = E.keep(cur);
        if (!keep_acc)
#pragma unroll
        for (int a = 0; a < 2; ++a)
#pragma unroll
            for (int b = 0; b < 2; ++b)
#pragma unroll
                for (int m = 0; m < 4; ++m)
#pragma unroll
                    for (int n = 0; n < 2; ++n) acc[a][b][m][n] = (f32x4){0.f, 0.f, 0.f, 0.f};
        cur = nxt; cA = nA; cB = nB; ++ui;
        if constexpr (ALIGN_EPI) { if (wr == 1) PG8_BAR; }
    }
    PG8_WAIT_V(0);
    if constexpr (!ALIGN_EPI) { if (wr == 0) PG8_BAR; }
    PG8_BAR;
#undef PG8_SA
#undef PG8_SB
#undef PG8_STAGE
#undef PG8_LDA
#undef PG8_LDB
#undef PG8_MMA
#undef PG8_WAIT_V
#undef PG8_WAIT_L
#undef PG8_BAR
#undef PG8_SCHED
#undef PG8_BASEA
#undef PG8_BASEB
}

__device__ __forceinline__ int opq(int x) { asm volatile("" : "+v"(x)); return x; }
typedef float f32x2 __attribute__((ext_vector_type(2)));
__device__ __forceinline__ float sigmoidf_(float z) { return __builtin_amdgcn_rcpf(1.0f + __builtin_amdgcn_exp2f(-z * LOG2E)); }
__device__ __forceinline__ float sumsq8(f32x4 a, f32x4 b) { return (a[0] * a[0] + a[1] * a[1]) + (a[2] * a[2] + a[3] * a[3]) + (b[0] * b[0] + b[1] * b[1]) + (b[2] * b[2] + b[3] * b[3]); }
__device__ __forceinline__ void rope8(f32x4& v0, f32x4& v1, const f32x2* cs) {
    const f32x4 c01 = *(const f32x4*)cs, c23 = *(const f32x4*)(cs + 2);
    f32x4 o0, o1;
    o0[0] = v0[0] * c01[0] - v0[1] * c01[1]; o0[1] = v0[1] * c01[0] + v0[0] * c01[1];
    o0[2] = v0[2] * c01[2] - v0[3] * c01[3]; o0[3] = v0[3] * c01[2] + v0[2] * c01[3];
    o1[0] = v1[0] * c23[0] - v1[1] * c23[1]; o1[1] = v1[1] * c23[0] + v1[0] * c23[1];
    o1[2] = v1[2] * c23[2] - v1[3] * c23[3]; o1[3] = v1[3] * c23[2] + v1[2] * c23[3];
    v0 = o0; v1 = o1;
}

struct EpiProj {
    static constexpr bool HAS_KEEP = false;
    bf16_t *QA; long dQKV; bf16_t *CQ, *CKV, *KR, *GATE; float *ssq_cq, *ssq_ckv; const float* b_gate; const f32x2* ropetab;
    __device__ __forceinline__ void operator()(f32x4 (&acc)[2][2][4][2], const Unit& u, int wr, int wc, int fr, int fq) const {
        const int pn = u.pn, row0 = u.pm * BM + wr * 64 + fr, cw = wc * 32 + 8 * fq;
        if (pn < 6) {
            bf16_t* base = QA + (long)(pn >> 1) * dQKV; const float sc = pn < 2 ? C2_MOBA : 1.0f; const int colt = (pn & 1) * 256 + cw;
#pragma unroll
            for (int ai = 0; ai < 2; ++ai)
#pragma unroll
                for (int m = 0; m < 4; ++m) { bf16_t* rowp = base + (size_t)opq(row0 + ai * HALF + m * 16) * 512 + colt;
#pragma unroll
                    for (int bj = 0; bj < 2; ++bj) *(u32x4*)(rowp + bj * HALF) = pack8(acc[ai][bj][m][0] * sc, acc[ai][bj][m][1] * sc); }
        } else if (pn == 6) {
#pragma unroll
            for (int ai = 0; ai < 2; ++ai)
#pragma unroll
                for (int m = 0; m < 4; ++m) { const int row = opq(row0 + ai * HALF + m * 16); bf16_t* rowp = CQ + (size_t)row * 256 + cw; float ss = 0.f;
#pragma unroll
                    for (int bj = 0; bj < 2; ++bj) { ss += sumsq8(acc[ai][bj][m][0], acc[ai][bj][m][1]); *(u32x4*)(rowp + bj * HALF) = pack8(acc[ai][bj][m][0], acc[ai][bj][m][1]); }
                    ss += __shfl_xor(ss, 16); ss += __shfl_xor(ss, 32);
                    if (fq == 0) atomicAdd(ssq_cq + row, ss); }
        } else if (pn == 7) {
#pragma unroll
            for (int ai = 0; ai < 2; ++ai)
#pragma unroll
                for (int m = 0; m < 4; ++m) { const int row = opq(row0 + ai * HALF + m * 16);
                    float ss = sumsq8(acc[ai][0][m][0], acc[ai][0][m][1]);
                    *(u32x4*)(CKV + (size_t)row * 128 + cw) = pack8(acc[ai][0][m][0], acc[ai][0][m][1]);
                    ss += __shfl_xor(ss, 16); ss += __shfl_xor(ss, 32);
                    if (fq == 0) atomicAdd(ssq_ckv + row, ss);
                    if (wc == 0) { f32x4 v0 = acc[ai][1][m][0], v1 = acc[ai][1][m][1];
                        rope8(v0, v1, ropetab + (size_t)(row & (SEQ - 1)) * 16 + 4 * fq);
                        *(u32x4*)(KR + (size_t)row * 32 + 8 * fq) = pack8(v0, v1); } }
        } else {
            const int gc = (pn - 8) * 256 + cw;
            f32x4 bv[2][2];
#pragma unroll
            for (int bj = 0; bj < 2; ++bj) { bv[bj][0] = *(const f32x4*)(b_gate + gc + bj * HALF); bv[bj][1] = *(const f32x4*)(b_gate + gc + bj * HALF + 4); }
#pragma unroll
            for (int ai = 0; ai < 2; ++ai)
#pragma unroll
                for (int m = 0; m < 4; ++m) { bf16_t* rowp = GATE + (size_t)opq(row0 + ai * HALF + m * 16) * 2048 + gc;
#pragma unroll
                    for (int bj = 0; bj < 2; ++bj) { f32x4 v0 = acc[ai][bj][m][0] + bv[bj][0], v1 = acc[ai][bj][m][1] + bv[bj][1];
#pragma unroll
                        for (int i = 0; i < 4; ++i) { v0[i] = sigmoidf_(v0[i]); v1[i] = sigmoidf_(v1[i]); }
                        *(u32x4*)(rowp + bj * HALF) = pack8(v0, v1); } }
        }
    }
};

struct EpiQup {
    static constexpr bool HAS_KEEP = false;
    bf16_t* QM; const float* ssq_cq; const f32x2* ropetab;
    __device__ __forceinline__ void operator()(f32x4 (&acc)[2][2][4][2], const Unit& u, int wr, int wc, int fr, int fq) const {
        const int row0 = u.pm * BM + wr * 64 + fr, c0 = u.pn * BM + wc * 32 + 8 * fq;
#pragma unroll
        for (int ai = 0; ai < 2; ++ai)
#pragma unroll
            for (int m = 0; m < 4; ++m) { const int row = opq(row0 + ai * HALF + m * 16);
                const float sc = __builtin_amdgcn_rsqf(ssq_cq[row] * (1.0f / 256.0f) + EPS) * C2_MLA;
#pragma unroll
                for (int bj = 0; bj < 2; ++bj) {
                    f32x4 v0 = acc[ai][bj][m][0] * sc, v1 = acc[ai][bj][m][1] * sc;
                    *(u32x4*)(QM + (size_t)row * 768 + c0 + bj * HALF) = pack8(v0, v1); asm volatile("" ::: "memory"); } }
    }
};
struct EpiKVup {
    static constexpr bool HAS_KEEP = false;
    bf16_t *KN; long dKV; const float* ssq_ckv;
    __device__ __forceinline__ void operator()(f32x4 (&acc)[2][2][4][2], const Unit& u, int wr, int wc, int fr, int fq) const {
        const int row0 = u.pm * BM + wr * 64 + fr, c0 = (u.pn & 1) * BM + wc * 32 + 8 * fq; bf16_t* base = KN + (long)(u.pn >> 1) * dKV;
#pragma unroll
        for (int ai = 0; ai < 2; ++ai)
#pragma unroll
            for (int m = 0; m < 4; ++m) { const int row = opq(row0 + ai * HALF + m * 16);
                const float sc = __builtin_amdgcn_rsqf(ssq_ckv[row] * (1.0f / 128.0f) + EPS);
#pragma unroll
                for (int bj = 0; bj < 2; ++bj) *(u32x4*)(base + (size_t)row * 512 + c0 + bj * HALF) = pack8(acc[ai][bj][m][0] * sc, acc[ai][bj][m][1] * sc); }
    }
};
struct EpiMix {
    static constexpr bool HAS_KEEP = true;
    const bf16_t* GATE; bf16_t* MIX;
    __device__ __forceinline__ bool keep(const Unit& u) const { return u.z == 0; }
    __device__ __forceinline__ void operator()(f32x4 (&acc)[2][2][4][2], const Unit& u, int wr, int wc, int fr, int fq) const {
        const int row0 = u.pm * BM + wr * 64 + fr, c0 = u.pn * BM + wc * 32 + 8 * fq;
#pragma unroll
        for (int ai = 0; ai < 2; ++ai)
#pragma unroll
            for (int m = 0; m < 4; ++m) { const int row = opq(row0 + ai * HALF + m * 16);
#pragma unroll
                for (int bj = 0; bj < 2; ++bj) { const int c = c0 + bj * HALF;
                    f32x4 ga, gb; unpack8(*(const u32x4*)(GATE + (size_t)row * 2048 + 1024 + c), ga, gb);
                    if (u.z == 0) { f32x4 ha, hb; unpack8(*(const u32x4*)(GATE + (size_t)row * 2048 + c), ha, hb);
#pragma unroll
                        for (int i = 0; i < 4; ++i) { ha[i] *= __builtin_amdgcn_rcpf(fmaxf(ga[i], 1e-30f)); hb[i] *= __builtin_amdgcn_rcpf(fmaxf(gb[i], 1e-30f)); }
                        acc[ai][bj][m][0] *= ha; acc[ai][bj][m][1] *= hb; }
                    else *(u32x4*)(MIX + (size_t)row * 1024 + c) = pack8(acc[ai][bj][m][0] * ga, acc[ai][bj][m][1] * gb);
                    asm volatile("" ::: "memory"); } }
    }
};
struct EpiOut {
    static constexpr bool HAS_KEEP = false;
    const float* X; float* OUT; bf16_t* H1B; float* ssq;
    __device__ __forceinline__ void operator()(f32x4 (&acc)[2][2][4][2], const Unit& u, int wr, int wc, int fr, int fq) const {
        const int row0 = u.pm * BM + wr * 64 + fr, c0 = u.pn * BM + wc * 32 + 8 * fq;
#pragma unroll
        for (int ai = 0; ai < 2; ++ai)
#pragma unroll
            for (int m = 0; m < 4; ++m) { const int row = opq(row0 + ai * HALF + m * 16); float ss = 0.f;
#pragma unroll
                for (int bj = 0; bj < 2; ++bj) { const size_t off = (size_t)row * 1024 + c0 + bj * HALF;
                    const f32x4 v0 = acc[ai][bj][m][0] + *(const f32x4*)(X + off), v1 = acc[ai][bj][m][1] + *(const f32x4*)(X + off + 4);
                    *(f32x4*)(OUT + off) = v0; *(f32x4*)(OUT + off + 4) = v1; *(u32x4*)(H1B + off) = pack8(v0, v1); ss += sumsq8(v0, v1); }
                ss += __shfl_xor(ss, 16); ss += __shfl_xor(ss, 32);
                if (fq == 0) atomicAdd(ssq + row, ss); }
    }
};
struct EpiUp {
    static constexpr bool HAS_KEEP = false;
    bf16_t *U, *UH; const float* ssq;
    __device__ __forceinline__ void operator()(f32x4 (&acc)[2][2][4][2], const Unit& u, int wr, int wc, int fr, int fq) const {
        const int row0 = u.pm * BM + wr * 64 + fr, c0 = u.pn * BM + wc * 32 + 8 * fq;
#pragma unroll
        for (int ai = 0; ai < 2; ++ai)
#pragma unroll
            for (int m = 0; m < 4; ++m) { const int row = opq(row0 + ai * HALF + m * 16);
                const float sc = __builtin_amdgcn_rsqf(ssq[row] * (1.0f / 1024.0f) + EPS);
                const bool halo = (row & 31) >= 30;
#pragma unroll
                for (int bj = 0; bj < 2; ++bj) { const u32x4 w = pack8(acc[ai][bj][m][0] * sc, acc[ai][bj][m][1] * sc);
                    *(u32x4*)(U + (size_t)row * DFF2 + c0 + bj * HALF) = w;
                    if (halo) *(u32x4*)(UH + ((size_t)(row >> 5) * 2 + (row & 1)) * DFF2 + c0 + bj * HALF) = w; } }
    }
};
struct EpiDown {
    static constexpr bool HAS_KEEP = false;
    float* OUT; float* ssq;
    __device__ __forceinline__ void operator()(f32x4 (&acc)[2][2][4][2], const Unit& u, int wr, int wc, int fr, int fq) const {
        const int row0 = u.pm * BM + wr * 64 + fr, c0 = u.pn * BM + wc * 32 + 8 * fq;
#pragma unroll
        for (int ai = 0; ai < 2; ++ai)
#pragma unroll
            for (int m = 0; m < 4; ++m) { const int row = opq(row0 + ai * HALF + m * 16); float ss = 0.f;
#pragma unroll
                for (int bj = 0; bj < 2; ++bj) { const size_t off = (size_t)row * 1024 + c0 + bj * HALF;
                    const f32x4 v0 = acc[ai][bj][m][0] + *(const f32x4*)(OUT + off), v1 = acc[ai][bj][m][1] + *(const f32x4*)(OUT + off + 4);
                    *(f32x4*)(OUT + off) = v0; *(f32x4*)(OUT + off + 4) = v1; ss += sumsq8(v0, v1); }
                ss += __shfl_xor(ss, 16); ss += __shfl_xor(ss, 32);
                if (fq == 0) atomicAdd(ssq + row, ss); }
    }
};
}

namespace att {
typedef unsigned short bf16;
typedef short bf16x8 __attribute__((ext_vector_type(8)));
typedef short s16x4 __attribute__((ext_vector_type(4)));
typedef float f32x16 __attribute__((ext_vector_type(16)));
typedef unsigned u32x4 __attribute__((ext_vector_type(4)));
#define SBAR() __builtin_amdgcn_sched_barrier(0)
constexpr int KVBLK = 64, QBLK = 32, QB = 256;
constexpr int V_BYTES = 8192, K_BYTES = 13312;
constexpr int OFF_V = 0, OFF_K = 2 * V_BYTES, OFF_WS = OFF_K + 2 * K_BYTES, OFF_BT = OFF_WS + 8 * 256, OFF_KM = OFF_BT + 512, LDS_BYTES = OFF_KM + 32 * 144;
constexpr float THR = 8.0f;
__device__ __forceinline__ int crow(int r, int hi) { return (r & 3) + 8 * (r >> 2) + 4 * hi; }
__device__ __forceinline__ unsigned cvtpk(float lo, float hi) { return pg8::cvt_pk_bf16(lo, hi); }
__device__ __forceinline__ int v_st(int k, int c) { const int kk = (k & ~0xC) | ((k & 4) << 1) | ((k & 8) >> 1); return ((kk >> 3) * 2 + (c >> 5)) * 512 + ((kk & 7) * 32 + (c & 31)) * 2; }
__device__ __forceinline__ int v_rd_base(int lane) { return ((lane & 3) << 3) | (((lane >> 2) & 3) << 6) | (((lane >> 4) & 1) << 5) | (((lane >> 5) & 1) << 8); }
constexpr int v_rd_off(int d0, int ks, int half) { return d0 * 512 + ks * 2048 + half * 1024; }
template <int OFF> __device__ __forceinline__ s16x4 tr_read(int vb) { s16x4 r; asm volatile("ds_read_b64_tr_b16 %0, %1 offset:%2" : "=&v"(r) : "v"(vb), "i"(OFF) : "memory"); return r; }

__device__ __forceinline__ void partialSM(f32x16& p0, f32x16& p1, float& m_reg, float& alpha) {
    float pmax = p0[0];
#pragma unroll
    for (int r = 1; r < 16; ++r) pmax = fmaxf(pmax, p0[r]);
#pragma unroll
    for (int r = 0; r < 16; ++r) pmax = fmaxf(pmax, p1[r]);
    { auto rr = __builtin_amdgcn_permlane32_swap(__float_as_uint(pmax), __float_as_uint(pmax), false, false); pmax = fmaxf(__uint_as_float(rr[0]), __uint_as_float(rr[1])); }
    float mn;
    if (__builtin_expect(__all(pmax - m_reg <= THR), 1)) { mn = m_reg; alpha = 1.f; }
    else { mn = fmaxf(m_reg, pmax); alpha = __builtin_amdgcn_exp2f(m_reg - mn); m_reg = mn; }
#pragma unroll
    for (int r = 0; r < 16; ++r) { p0[r] -= mn; p1[r] -= mn; }
#pragma unroll
    for (int r = 0; r < 16; ++r) p0[r] = __builtin_amdgcn_exp2f(p0[r]);
}
__device__ __forceinline__ void finishSM(f32x16& p0, f32x16& p1, float alpha, float& l_reg, bf16x8& pa0, bf16x8& pa1, bf16x8& pa2, bf16x8& pa3) {
#pragma unroll
    for (int r = 0; r < 16; ++r) p1[r] = __builtin_amdgcn_exp2f(p1[r]);
    float ps = 0;
#pragma unroll
    for (int r = 0; r < 16; ++r) ps += p0[r];
#pragma unroll
    for (int r = 0; r < 16; ++r) ps += p1[r];
    { auto rr = __builtin_amdgcn_permlane32_swap(__float_as_uint(ps), __float_as_uint(ps), false, false); ps = __uint_as_float(rr[0]) + __uint_as_float(rr[1]); }
    l_reg = l_reg * alpha + ps;
#define PK4(P, BASE, OUT) do { unsigned a0 = cvtpk(P[BASE + 0], P[BASE + 1]), a1 = cvtpk(P[BASE + 2], P[BASE + 3]);   \
    unsigned b0 = cvtpk(P[BASE + 4], P[BASE + 5]), b1 = cvtpk(P[BASE + 6], P[BASE + 7]);                              \
    auto r0 = __builtin_amdgcn_permlane32_swap(a0, b0, false, false); auto r1 = __builtin_amdgcn_permlane32_swap(a1, b1, false, false); \
    u32x4 w = {r0[0], r1[0], r0[1], r1[1]}; OUT = *reinterpret_cast<bf16x8*>(&w); } while (0)
    PK4(p0, 0, pa0); PK4(p0, 8, pa1); PK4(p1, 0, pa2); PK4(p1, 8, pa3);
#undef PK4
}
template <int D0> __device__ __forceinline__ void pv_one(f32x16& od, int vb, bf16x8 pa0, bf16x8 pa1, bf16x8 pa2, bf16x8 pa3) {
    const s16x4 l0 = tr_read<v_rd_off(D0, 0, 0)>(vb), h0 = tr_read<v_rd_off(D0, 0, 1)>(vb), l1 = tr_read<v_rd_off(D0, 1, 0)>(vb), h1 = tr_read<v_rd_off(D0, 1, 1)>(vb);
    const s16x4 l2 = tr_read<v_rd_off(D0, 2, 0)>(vb), h2 = tr_read<v_rd_off(D0, 2, 1)>(vb), l3 = tr_read<v_rd_off(D0, 3, 0)>(vb), h3 = tr_read<v_rd_off(D0, 3, 1)>(vb);
    asm volatile("s_waitcnt lgkmcnt(0)" ::: "memory"); SBAR();
#define PK(L, H) (bf16x8){L[0], L[1], L[2], L[3], H[0], H[1], H[2], H[3]}
    od = __builtin_amdgcn_mfma_f32_32x32x16_bf16(pa0, PK(l0, h0), od, 0, 0, 0);
    od = __builtin_amdgcn_mfma_f32_32x32x16_bf16(pa1, PK(l1, h1), od, 0, 0, 0);
    od = __builtin_amdgcn_mfma_f32_32x32x16_bf16(pa2, PK(l2, h2), od, 0, 0, 0);
    od = __builtin_amdgcn_mfma_f32_32x32x16_bf16(pa3, PK(l3, h3), od, 0, 0, 0);
#undef PK
}

struct Args { const bf16* Q; const bf16* K; const bf16* KR; const bf16* V; bf16* O; const bf16* kmean; const float* btab; const float* ropetab; int ldq; };

template <bool MOBA> __device__ __forceinline__ void mask_tile(f32x16& p0, f32x16& p1, int t, int NT, int wid, int r32, int hi, unsigned selmask, const float* btl) {
    const float NEG = -__builtin_inff();
    const int tb = t - (NT - 4);
    const int minrel = 32 * wid - 64 * tb - 63;
    const int qrel = 32 * wid + r32;
    if constexpr (MOBA) {
        if (tb >= -2 && minrel < 113) {
#pragma unroll
            for (int r = 0; r < 16; ++r) { const int rel = qrel - (64 * tb + crow(r, hi)); const int rel1 = rel - 32;
                const float b0 = btl[rel < 0 ? 0 : (rel > 127 ? 127 : rel)], b1 = btl[rel1 < 0 ? 0 : (rel1 > 127 ? 127 : rel1)];
                p0[r] = rel < 0 ? NEG : p0[r] + b0; p1[r] = rel1 < 0 ? NEG : p1[r] + b1; }
        }
        if (tb < 0 && !((selmask >> (t >> 2)) & 1u)) {
#pragma unroll
            for (int r = 0; r < 16; ++r) { p0[r] = NEG; p1[r] = NEG; }
        }
    } else {
        if (tb >= 0 && minrel < 0) {
#pragma unroll
            for (int r = 0; r < 16; ++r) { const int rel = qrel - (64 * tb + crow(r, hi));
                p0[r] = rel < 0 ? NEG : p0[r]; p1[r] = rel - 32 < 0 ? NEG : p1[r]; }
        }
    }
}

template <int DQK, bool MOBA> __device__ __forceinline__ void attn_unit(const Args& a, int b, int h, int qb, char* lds) {
    constexpr int KST = DQK * 2 + 16, ND = DQK / 16;
    int tid_ = threadIdx.x; asm volatile("" : "+v"(tid_));
    const int tid = tid_, lane = tid & 63, r32 = lane & 31, hi = lane >> 5; const int wid = __builtin_amdgcn_readfirstlane(tid >> 6);
    char* Vl = lds + OFF_V; char* Kl = lds + OFF_K;
    float* ws = (float*)(lds + OFF_WS) + wid * 64; float* li_l = ws; float* al_l = ws + 32; const float* btl = (const float*)(lds + OFF_BT);
    const long rowbase = (long)b * SEQ; const int q0 = qb * QB, NT = 4 * (qb + 1);
    bf16x8 qr[ND];
    { const bf16* Qw = a.Q + (rowbase + q0 + wid * QBLK + r32) * a.ldq + hi * 8;
#pragma unroll
      for (int d0 = 0; d0 < ND; ++d0) qr[d0] = *(const bf16x8*)(Qw + (d0 < 4 ? h * 64 + d0 * 16 : 512 + h * 32 + (d0 - 4) * 16)); }
    if constexpr (DQK == 96) {
        typedef float f32x4_ __attribute__((ext_vector_type(4)));
        const float* rt = a.ropetab + ((size_t)(q0 + wid * QBLK + r32) * 16 + 4 * hi) * 2;
#pragma unroll
        for (int d0 = 4; d0 < 6; ++d0) { const f32x4_ c01 = *(const f32x4_*)(rt + (d0 - 4) * 16), c23 = *(const f32x4_*)(rt + (d0 - 4) * 16 + 4);
            u32x4 w = *reinterpret_cast<u32x4*>(&qr[d0]); float x[8];
#pragma unroll
            for (int i = 0; i < 4; ++i) { x[2 * i] = __uint_as_float(w[i] << 16); x[2 * i + 1] = __uint_as_float(w[i] & 0xffff0000u); }
            u32x4 o;
            o[0] = cvtpk(x[0] * c01[0] - x[1] * c01[1], x[1] * c01[0] + x[0] * c01[1]); o[1] = cvtpk(x[2] * c01[2] - x[3] * c01[3], x[3] * c01[2] + x[2] * c01[3]);
            o[2] = cvtpk(x[4] * c23[0] - x[5] * c23[1], x[5] * c23[0] + x[4] * c23[1]); o[3] = cvtpk(x[6] * c23[2] - x[7] * c23[3], x[7] * c23[2] + x[6] * c23[3]);
            qr[d0] = *reinterpret_cast<bf16x8*>(&o); }
    }
    const int sr = tid >> 3, sc8 = tid & 7;
    const bf16* Kg = a.K + (rowbase + sr) * 512 + h * 64 + sc8 * 8;
    const bf16* Vg = a.V + (rowbase + sr) * 512 + h * 64 + sc8 * 8;
    const bf16* KRg = a.KR + (rowbase + (tid >> 2)) * 32 + (tid & 3) * 8;
    const int kst_off = sr * KST + sc8 * 16, krst_off = (tid >> 2) * KST + 128 + (tid & 3) * 16, vst_off = v_st(sr, sc8 * 8);
    const int vb0 = (int)(uintptr_t)Vl + v_rd_base(lane);
    struct { bf16x8 k, v, kr; } sr_[2];
#define SLOAD(i, k0) do { sr_[i].k = *(const bf16x8*)(Kg + (long)(k0) * 512); sr_[i].v = *(const bf16x8*)(Vg + (long)(k0) * 512); \
        if (DQK == 96 && wid < 4) sr_[i].kr = *(const bf16x8*)(KRg + (long)(k0) * 32); } while (0)
#define SWRITE(bf, i) do { *(bf16x8*)(Kl + (bf) * K_BYTES + kst_off) = sr_[i].k; *(bf16x8*)(Vl + (bf) * V_BYTES + vst_off) = sr_[i].v; \
        if (DQK == 96 && wid < 4) *(bf16x8*)(Kl + (bf) * K_BYTES + krst_off) = sr_[i].kr; } while (0)
#define QKT(P0, P1, bf) do { const char* Ks_ = Kl + (bf) * K_BYTES; P0 = f32x16{}; P1 = f32x16{}; \
        _Pragma("unroll") for (int d0 = 0; d0 < ND; ++d0) { \
            const bf16x8 b0_ = *(const bf16x8*)(Ks_ + r32 * KST + (2 * d0 + hi) * 16), b1_ = *(const bf16x8*)(Ks_ + (32 + r32) * KST + (2 * d0 + hi) * 16); \
            P0 = __builtin_amdgcn_mfma_f32_32x32x16_bf16(b0_, qr[d0], P0, 0, 0, 0); P1 = __builtin_amdgcn_mfma_f32_32x32x16_bf16(b1_, qr[d0], P1, 0, 0, 0); } } while (0)
#define PV(bf) do { pv_one<0>(o[0], vb0 + (bf) * V_BYTES, pa0, pa1, pa2, pa3); pv_one<1>(o[1], vb0 + (bf) * V_BYTES, pa0, pa1, pa2, pa3); } while (0)
#define RESC(al) do { if (__any((al) < 1.f)) { if (hi == 0) al_l[r32] = (al); asm volatile("s_waitcnt lgkmcnt(0)" ::: "memory"); \
        _Pragma("unroll") for (int d = 0; d < 2; ++d) _Pragma("unroll") for (int r = 0; r < 16; ++r) o[d][r] *= al_l[crow(r, hi)]; } } while (0)
    unsigned selmask = 0xffffffffu;
    if constexpr (MOBA) {
        if (tid < 256) *(bf16x8*)(lds + OFF_KM + (tid >> 3) * 144 + (tid & 7) * 16) = *(const bf16x8*)(a.kmean + ((long)(b * 8 + h) * 32 + (tid >> 3)) * 64 + (tid & 7) * 8);
        else if (tid < 384) ((float*)(lds + OFF_BT))[tid - 256] = a.btab[h * 128 + tid - 256];
        __syncthreads();
        if (qb > 3) {
            f32x16 g = f32x16{};
#pragma unroll
            for (int d0 = 0; d0 < 4; ++d0) { const bf16x8 ka = *(const bf16x8*)(lds + OFF_KM + r32 * 144 + (2 * d0 + hi) * 16); g = __builtin_amdgcn_mfma_f32_32x32x16_bf16(ka, qr[d0], g, 0, 0, 0); }
            const float NEG = -__builtin_inff();
#pragma unroll
            for (int r = 0; r < 16; ++r) g[r] = crow(r, hi) < qb ? g[r] : NEG;
            float m1 = NEG, m2 = NEG, m3 = NEG;
#pragma unroll
            for (int r = 0; r < 16; ++r) m1 = fmaxf(m1, g[r]);
            { auto rr = __builtin_amdgcn_permlane32_swap(__float_as_uint(m1), __float_as_uint(m1), false, false); m1 = fmaxf(__uint_as_float(rr[0]), __uint_as_float(rr[1])); }
#pragma unroll
            for (int r = 0; r < 16; ++r) m2 = fmaxf(m2, g[r] < m1 ? g[r] : NEG);
            { auto rr = __builtin_amdgcn_permlane32_swap(__float_as_uint(m2), __float_as_uint(m2), false, false); m2 = fmaxf(__uint_as_float(rr[0]), __uint_as_float(rr[1])); }
#pragma unroll
            for (int r = 0; r < 16; ++r) m3 = fmaxf(m3, g[r] < m2 ? g[r] : NEG);
            { auto rr = __builtin_amdgcn_permlane32_swap(__float_as_uint(m3), __float_as_uint(m3), false, false); m3 = fmaxf(__uint_as_float(rr[0]), __uint_as_float(rr[1])); }
            unsigned bits = 0u;
#pragma unroll
            for (int r = 0; r < 16; ++r) bits |= (g[r] >= m3) ? (1u << crow(r, hi)) : 0u;
            { auto rr = __builtin_amdgcn_permlane32_swap(bits, bits, false, false); selmask = rr[0] | rr[1]; }
        }
    }
    float m_reg = -1e30f, l_reg = 0.f; f32x16 o[2]; o[0] = f32x16{}; o[1] = f32x16{};
    f32x16 pA0, pA1, pB0, pB1; float alA, alB; bf16x8 pa0, pa1, pa2, pa3;
    SLOAD(0, 0); SWRITE(0, 0); __syncthreads();
    QKT(pA0, pA1, 0); mask_tile<MOBA>(pA0, pA1, 0, NT, wid, r32, hi, selmask, btl); partialSM(pA0, pA1, m_reg, alA);
    SLOAD(1, KVBLK); if (2 < NT) SLOAD(0, 2 * KVBLK);
    SWRITE(1, 1); __syncthreads();
    for (int j = 1; j + 1 < NT; j += 2) {
        SBAR(); QKT(pB0, pB1, 1);
        finishSM(pA0, pA1, alA, l_reg, pa0, pa1, pa2, pa3); SBAR();
        SLOAD(1, (j + 2) * KVBLK); SBAR();
        PV(0); mask_tile<MOBA>(pB0, pB1, j, NT, wid, r32, hi, selmask, btl); partialSM(pB0, pB1, m_reg, alB);
        __syncthreads(); SWRITE(0, 0);
        RESC(alB); __syncthreads();
        SBAR(); QKT(pA0, pA1, 0);
        finishSM(pB0, pB1, alB, l_reg, pa0, pa1, pa2, pa3); SBAR();
        if (j + 3 < NT) SLOAD(0, (j + 3) * KVBLK); SBAR();
        PV(1); mask_tile<MOBA>(pA0, pA1, j + 1, NT, wid, r32, hi, selmask, btl); partialSM(pA0, pA1, m_reg, alA);
        __syncthreads(); SWRITE(1, 1);
        RESC(alA); __syncthreads();
    }
    SBAR(); QKT(pB0, pB1, 1);
    finishSM(pA0, pA1, alA, l_reg, pa0, pa1, pa2, pa3); SBAR();
    PV(0); mask_tile<MOBA>(pB0, pB1, NT - 1, NT, wid, r32, hi, selmask, btl); partialSM(pB0, pB1, m_reg, alB);
    __syncthreads(); RESC(alB);
    finishSM(pB0, pB1, alB, l_reg, pa0, pa1, pa2, pa3); SBAR();
    PV(1);
    if (hi == 0) li_l[r32] = l_reg; asm volatile("s_waitcnt lgkmcnt(0)" ::: "memory");
    bf16* Ow = a.O + (rowbase + q0 + wid * QBLK) * 512 + h * 64 + r32;
#pragma unroll
    for (int r = 0; r < 16; ++r) { const int orow = crow(r, hi); const float rl = __builtin_amdgcn_rcpf(li_l[orow]);
        const unsigned w0 = cvtpk(o[0][r] * rl, o[1][r] * rl);
        Ow[(long)orow * 512] = (bf16)(w0 & 0xffffu); Ow[(long)orow * 512 + 32] = (bf16)(w0 >> 16); }
    __syncthreads();
#undef SLOAD
#undef SWRITE
#undef QKT
#undef PV
#undef RESC
}
#undef SBAR
}

constexpr int NWAVES = 8;
constexpr size_t MiB = 1u << 20;
constexpr size_t WS_CTL = 0, CTL_ZERO_BYTES = 1 * MiB;
constexpr size_t WS_ROPE = 1 * MiB;
constexpr size_t WS_SSQ = 2 * MiB;
constexpr size_t WS_KMEAN = 2 * MiB + 512 * 1024;
constexpr size_t WS_BTAB = 2 * MiB + 768 * 1024;
constexpr size_t WS_BT1 = 4 * MiB, WS_BT2 = 12 * MiB, WS_BT2B = 12 * MiB + 512 * 1024, WS_BT3A = 13 * MiB, WS_BT3B = 14 * MiB, WS_BT4 = 15 * MiB, WS_BT5 = 17 * MiB, WS_BT6 = 28 * MiB;
constexpr size_t WS_BASE = 38 * MiB;
constexpr size_t WS_XN = WS_BASE, WS_QM = WS_BASE, WS_MIX = WS_BASE;
constexpr size_t WS_QA = 102 * MiB, WS_KA = 134 * MiB, WS_VA = 166 * MiB;
constexpr size_t WS_SCR = WS_QA;
constexpr size_t WS_CQ = 198 * MiB, WS_CKV = 214 * MiB, WS_KR = 222 * MiB;
constexpr size_t WS_GATE = 224 * MiB;
constexpr size_t WS_KN = 352 * MiB, WS_VM = 384 * MiB, WS_YA = 416 * MiB, WS_YB = 448 * MiB;
constexpr size_t WS_U = WS_BASE;
constexpr size_t WS_H1B = 390 * MiB;
constexpr size_t WS_UH = 454 * MiB;
constexpr size_t WS_END = 480 * MiB;
constexpr int CW_TMO = 0, CW_CODE = 1, CW_BAR = 4096;

constexpr int RING_OFF = 0, RING_BYTES = 131072;
constexpr int LDSCTL_OFF = RING_BYTES, MISC_OFF = LDSCTL_OFF + 320;
constexpr int LDS_BYTES = 147456;
static_assert(att::LDS_BYTES <= RING_BYTES, "attention scratch fits the ring region");

#define GAS __attribute__((address_space(1)))
#define LAS __attribute__((address_space(3)))
typedef unsigned short bf16;
typedef unsigned v4u __attribute__((ext_vector_type(4)));
typedef float f32x4 __attribute__((ext_vector_type(4)));
typedef float f32x2 __attribute__((ext_vector_type(2)));
typedef GAS unsigned gu32;
#define RLX_AGENT __ATOMIC_RELAXED, __HIP_MEMORY_SCOPE_AGENT
#define LDS_WAIT() asm volatile("s_waitcnt lgkmcnt(0)" ::: "memory")
#define VM_WAIT() asm volatile("s_waitcnt vmcnt(0)" ::: "memory")
__device__ __forceinline__ unsigned f2bf(float f) { unsigned u = __builtin_bit_cast(unsigned, f); return (u + 0x7fffu + ((u >> 16) & 1u)) >> 16; }
__device__ __forceinline__ unsigned pk2(float lo, float hi) { return f2bf(lo) | (f2bf(hi) << 16); }

#define XB_TMO      128
#define XB_XCNT(j)  (256  + 64 * (j))
#define XB_XSUB(j)  (1280 + 64 * (j))
#define XB_XGEN(j)  (2304 + 64 * (j))
#define XB_TOP      3328
#define XB_TOPGEN   3392
#define XCD_BAR_WORDS 3456
#define XB_SPIN_CAP (1u << 18)
__device__ __forceinline__ unsigned xb_ld(unsigned* p)              { return __hip_atomic_load(p, __ATOMIC_RELAXED, __HIP_MEMORY_SCOPE_AGENT); }
__device__ __forceinline__ unsigned xb_add(unsigned* p, unsigned v) { return __hip_atomic_fetch_add(p, v, __ATOMIC_RELAXED, __HIP_MEMORY_SCOPE_AGENT); }
__device__ __forceinline__ unsigned xb_xcc_id() { return (unsigned)__builtin_amdgcn_s_getreg((3 << 11) | 20) & 0xFu; }
#define XB_SPIN(cond, bar) do { unsigned _sp = 0; while (cond) { __builtin_amdgcn_s_sleep(1); \
    if ((++_sp & 255u) == 0u) { if (xb_ld(&(bar)[XB_TMO])) break; if (_sp > XB_SPIN_CAP) { atomicAdd(&(bar)[XB_TMO], 1u); break; } } } } while (0)
struct XcdBarrier { unsigned* bar; unsigned x; volatile LAS unsigned* st; };
__device__ __forceinline__ XcdBarrier xcd_barrier_post(unsigned* bar, volatile LAS unsigned* st) {
    XcdBarrier b; b.bar = bar; b.x = xb_xcc_id(); b.st = st;
    if (threadIdx.x == 0) (void)xb_add(&bar[XB_XCNT(b.x)], 1u);
    return b;
}
__device__ __forceinline__ void xcd_barrier_complete(unsigned* bar, unsigned x, unsigned& nloc, unsigned& nx) {
    const unsigned G = gridDim.x * gridDim.y * gridDim.z;
    unsigned sum, cnt, mine, sp = 0u;
    for (;;) {
        sum = 0u; cnt = 0u; mine = 0u;
#pragma unroll
        for (unsigned j = 0; j < 16; ++j) { const unsigned c = xb_ld(&bar[XB_XCNT(j)]); sum += c; cnt += (c > 0u) ? 1u : 0u; mine = (j == x) ? c : mine; }
        if (sum == G) break;
        __builtin_amdgcn_s_sleep(1);
        if ((++sp & 255u) == 0u) { if (xb_ld(&bar[XB_TMO])) break; if (sp > XB_SPIN_CAP) { atomicAdd(&bar[XB_TMO], 1u); break; } }
    }
    nloc = mine > 0u ? mine : 1u; nx = cnt > 0u ? cnt : 1u;
}
__device__ __forceinline__ void xcd_barrier(const XcdBarrier& b) {
    asm volatile("s_waitcnt vmcnt(0)" ::: "memory");
    __syncthreads();
    if (threadIdx.x == 0) {
        unsigned* bar = b.bar;
        __builtin_amdgcn_s_waitcnt(0);
        unsigned nloc = b.st[0], nx = b.st[1];
        if (nloc == 0u) { xcd_barrier_complete(bar, b.x, nloc, nx); b.st[0] = nloc; b.st[1] = nx; }
        const unsigned old = xb_add(&bar[XB_XSUB(b.x)], 1u);
        const unsigned gen = old / nloc;
        if (old + 1u == (gen + 1u) * nloc) {
            __builtin_amdgcn_fence(__ATOMIC_RELEASE, "agent");
            asm volatile("s_waitcnt vmcnt(0)" ::: "memory");
            const unsigned og = xb_add(&bar[XB_TOP], 1u);
            const unsigned tg = og / nx;
            if (og + 1u == (tg + 1u) * nx) xb_add(&bar[XB_TOPGEN], 1u);
            else XB_SPIN(xb_ld(&bar[XB_TOPGEN]) == tg, bar);
            __builtin_amdgcn_fence(__ATOMIC_ACQUIRE, "agent");
            xb_add(&bar[XB_XGEN(b.x)], 1u);
            asm volatile("s_waitcnt vmcnt(0)" ::: "memory");
        } else {
            XB_SPIN(xb_ld(&bar[XB_XGEN(b.x)]) == gen, bar);
            __builtin_amdgcn_fence(__ATOMIC_ACQUIRE, "agent");
            asm volatile("s_waitcnt vmcnt(0)" ::: "memory");
        }
    }
    __syncthreads();
}

__device__ __forceinline__ float wave_sum(float v) {
#pragma unroll
    for (int o = 1; o < 64; o <<= 1) v += __shfl_xor(v, o);
    return v;
}
struct MapId { __device__ __forceinline__ int operator()(int n) const { return n; } };
struct MapIn { __device__ __forceinline__ int operator()(int n) const {
    if (n < 1920) return n;
    if (n < 1952) { const int j = n - 1920; return 1920 + (j & 1) * 16 + (j >> 1); }
    if (n < 2048) return -1;
    return 1952 + (n - 2048); } };
struct MapUq { __device__ __forceinline__ int operator()(int n) const { if (n < 512) return (n >> 6) * 96 + (n & 63); const int h = (n - 512) >> 5, j = n & 31; return h * 96 + 64 + (j & 1) * 16 + (j >> 1); } };
struct MapUkv { __device__ __forceinline__ int operator()(int n) const { const int hh = (n & 511) >> 6, d = n & 63; return hh * 128 + (n >> 9) * 64 + d; } };
template <class CM> __device__ __forceinline__ void p0_transpose_item(const float* W, int K, int N, int NP, bf16* WT, const float* kscale, LAS float* scr, int item, int lane, CM cm) {
    const int nblk = NP / 32, kb = item / nblk, nb = item % nblk, k0 = 64 * kb, n0 = 32 * nb;
    const int sc = cm(n0 + (lane & 31));
#pragma unroll 8
    for (int i = 0; i < 32; ++i) { const int kk = 2 * i + (lane >> 5); float v = 0.f; if (sc >= 0) { v = W[(size_t)(k0 + kk) * N + sc]; if (kscale) v *= kscale[k0 + kk]; } scr[kk * 33 + (lane & 31)] = v; }
    LDS_WAIT(); asm volatile("" ::: "memory");
    const int c = lane & 7;
#pragma unroll
    for (int j = 0; j < 4; ++j) { const int n = (lane >> 3) + 8 * j; const LAS float* s = scr + (8 * c) * 33 + n;
        v4u o; o.x = pk2(s[0 * 33], s[1 * 33]); o.y = pk2(s[2 * 33], s[3 * 33]); o.z = pk2(s[4 * 33], s[5 * 33]); o.w = pk2(s[6 * 33], s[7 * 33]);
        *(GAS v4u*)(WT + (size_t)(n0 + n) * K + k0 + 8 * c) = o; }
    LDS_WAIT(); asm volatile("" ::: "memory");
}
__device__ const float INV_FREQ[16] = {1.000000000e+00f, 5.623413324e-01f, 3.162277639e-01f, 1.778279394e-01f, 1.000000015e-01f, 5.623413250e-02f, 3.162277490e-02f, 1.778279431e-02f,
                                       9.999999776e-03f, 5.623413250e-03f, 3.162277630e-03f, 1.778279431e-03f, 1.000000047e-03f, 5.623413017e-04f, 3.162277571e-04f, 1.778279402e-04f};
__device__ __forceinline__ void sincos_rev(float ang, float& s, float& c) {
    const float c_hi = 0.15915494309189535f;
    const float c_lo = (float)(0.15915494309189535 - (double)0.15915494309189535f);
    const float t_hi = ang * c_hi; const float t_lo = __builtin_fmaf(ang, c_hi, -t_hi) + ang * c_lo;
    float fr = (t_hi - __builtin_floorf(t_hi)) + t_lo;
    s = __builtin_amdgcn_sinf(fr); c = __builtin_amdgcn_cosf(fr);
}

#ifndef PHMASK
#define PHMASK 0x3ff
#endif
struct KArgs { const float* in[18]; float* out; unsigned char* ws; };


#ifdef DBG_STOP
#define DBG_DUMP(n) do { if (DBG_STOP == (n)) { PHASE_PTRS(); \
    for (int i = gt; i < T * 1024; i += NGT) { const int r = i >> 10, c = i & 1023; float v = 0.f; \
        if ((n) == 0) v = pg8::bf2f(XN[(size_t)r * 1024 + c]) + pg8::bf2f(Bt1[(size_t)(r & 4095) * 1024 + c]) + pg8::bf2f(Bt5[(size_t)(r % 5632) * 1024 + c]) + pg8::bf2f(Bt6[(size_t)(r & 1023) * 2816 + c]) + pg8::bf2f(Bt4[(size_t)(r & 1023) * 1024 + c]) + ropetab[(r & 8191) * 16 + (c & 15)].x; \
        if ((n) == 1) v = pg8::bf2f(QA[(size_t)r * 512 + (c & 511)]) + pg8::bf2f(KA[(size_t)r * 512 + (c & 511)]) + pg8::bf2f(VA[(size_t)r * 512 + (c & 511)]) + pg8::bf2f(CQ[(size_t)r * 256 + (c & 255)]) \
              + pg8::bf2f(CKV[(size_t)r * 128 + (c & 127)]) + pg8::bf2f(KR[(size_t)r * 32 + (c & 31)]) + pg8::bf2f(GATE[(size_t)r * 2048 + c]) + pg8::bf2f(GATE[(size_t)r * 2048 + 1024 + c]); \
        if ((n) == 2) v = pg8::bf2f(QM[(size_t)r * 768 + (c % 768)]) + pg8::bf2f(KN[(size_t)r * 512 + (c & 511)]) + pg8::bf2f(VM[(size_t)r * 512 + (c & 511)]) + pg8::bf2f(KMEAN[(size_t)(r & 1023) * 64 + (c & 63)]); \
        if ((n) == 3) v = (c < 512) ? pg8::bf2f(YA[(size_t)r * 512 + c]) : pg8::bf2f(YB[(size_t)r * 512 + (c & 511)]); \
        if ((n) == 4) v = pg8::bf2f(MIX[(size_t)r * 1024 + c]); \
        if ((n) == 5) v = pg8::bf2f(H1B[(size_t)r * 1024 + c]); \
        if ((n) == 6) v = pg8::bf2f(U[(size_t)r * 5632 + c]) + pg8::bf2f(U[(size_t)r * 5632 + 1024 + c]) + pg8::bf2f(U[(size_t)r * 5632 + 2048 + c]) + pg8::bf2f(U[(size_t)r * 5632 + 3072 + c]) + pg8::bf2f(U[(size_t)r * 5632 + 4096 + c]) + pg8::bf2f(U[(size_t)r * 5632 + 4608 + c]); \
        if ((n) == 7) v = pg8::bf2f(U[(size_t)r * 5632 + c]) + pg8::bf2f(U[(size_t)r * 5632 + 1024 + c]) + pg8::bf2f(U[(size_t)r * 5632 + 1792 + c]); \
        out[i] = v; } return; } } while (0)
#else
#define DBG_DUMP(n) do {} while (0)
#endif
#define PHASE_PTRS() \
    int tid = threadIdx.x; asm volatile("" : "+v"(tid)); const int lane = tid & 63, wave = __builtin_amdgcn_readfirstlane(tid >> 6); \
    const int gw = vcu * NWAVES + wave, NGW = G * NWAVES, gt = (vcu * NWAVES * 64) + tid, NGT = G * NWAVES * 64; (void)lane; (void)wave; (void)gw; (void)NGW; (void)gt; (void)NGT; \
    const KArgs __attribute__((address_space(4)))* ap_ = (const KArgs __attribute__((address_space(4)))*)__builtin_amdgcn_kernarg_segment_ptr(); asm volatile("" : "+s"(ap_)); unsigned char* ws = ap_->ws; (void)ws; \
    const float* x = ap_->in[0]; const float* norm_attn_g = ap_->in[1]; const float* w_in = ap_->in[2]; const float* b_gate = ap_->in[3]; \
    const float* q_norm_g = ap_->in[4]; const float* w_uq = ap_->in[5]; const float* kv_norm_g = ap_->in[6]; const float* w_ukv = ap_->in[7]; \
    const float* rel_bias = ap_->in[8]; const float* w_bm = ap_->in[9]; const float* w_bl = ap_->in[10]; const float* w_out = ap_->in[11]; \
    const float* norm_ffn_g = ap_->in[12]; const float* w_up = ap_->in[13]; const float* conv_w = ap_->in[14]; const float* conv_b = ap_->in[15]; \
    const float* w_down = ap_->in[16]; const float* norm_final_g = ap_->in[17]; float* out = ap_->out; \
    (void)x; (void)norm_attn_g; (void)w_in; (void)b_gate; (void)q_norm_g; (void)w_uq; (void)kv_norm_g; (void)w_ukv; (void)rel_bias; (void)w_bm; (void)w_bl; (void)w_out; \
    (void)norm_ffn_g; (void)w_up; (void)conv_w; (void)conv_b; (void)w_down; (void)norm_final_g; (void)out; \
    f32x2* ropetab = (f32x2*)(ws + WS_ROPE); (void)ropetab; \
    float* ssq_cq = (float*)(ws + WS_SSQ); float* ssq_ckv = ssq_cq + T; float* ssq_h1 = ssq_ckv + T; float* ssq_h2 = ssq_h1 + T; (void)ssq_cq; (void)ssq_ckv; (void)ssq_h1; (void)ssq_h2; \
    bf16* KMEAN = (bf16*)(ws + WS_KMEAN); float* BTAB = (float*)(ws + WS_BTAB); (void)KMEAN; (void)BTAB; \
    bf16 *Bt1 = (bf16*)(ws + WS_BT1), *Bt2 = (bf16*)(ws + WS_BT2), *Bt2b = (bf16*)(ws + WS_BT2B), *Bt3a = (bf16*)(ws + WS_BT3A), *Bt3b = (bf16*)(ws + WS_BT3B), \
         *Bt4 = (bf16*)(ws + WS_BT4), *Bt5 = (bf16*)(ws + WS_BT5), *Bt6 = (bf16*)(ws + WS_BT6); (void)Bt1; (void)Bt2; (void)Bt2b; (void)Bt3a; (void)Bt3b; (void)Bt4; (void)Bt5; (void)Bt6; \
    bf16 *XN = (bf16*)(ws + WS_XN), *QM = (bf16*)(ws + WS_QM), *MIX = (bf16*)(ws + WS_MIX), *QA = (bf16*)(ws + WS_QA), *KA = (bf16*)(ws + WS_KA), *VA = (bf16*)(ws + WS_VA), \
         *CQ = (bf16*)(ws + WS_CQ), *CKV = (bf16*)(ws + WS_CKV), *KR = (bf16*)(ws + WS_KR), *GATE = (bf16*)(ws + WS_GATE), *KN = (bf16*)(ws + WS_KN), *VM = (bf16*)(ws + WS_VM), \
         *YA = (bf16*)(ws + WS_YA), *YB = (bf16*)(ws + WS_YB), *U = (bf16*)(ws + WS_U), *H1B = (bf16*)(ws + WS_H1B), *UH = (bf16*)(ws + WS_UH); \
    (void)XN; (void)QM; (void)MIX; (void)QA; (void)KA; (void)VA; (void)CQ; (void)CKV; (void)KR; (void)GATE; (void)KN; (void)VM; (void)YA; (void)YB; (void)U; (void)H1B; (void)UH

__global__ void __launch_bounds__(NWAVES * 64, 2) hybrid_fwd(KArgs args) {
    extern __shared__ __attribute__((aligned(16))) unsigned char lds[];
    LAS unsigned char* ldsl = (LAS unsigned char*)lds;
    volatile LAS unsigned* MISC = (volatile LAS unsigned*)(ldsl + MISC_OFF);
    const int G = gridDim.x; const int bx = blockIdx.x; const int vcu = (G % 8 == 0) ? (bx % 8) * (G / 8) + bx / 8 : bx;
    gu32* ctl = (gu32*)(args.ws + WS_CTL);
    for (int u = threadIdx.x; u < (LDS_BYTES - LDSCTL_OFF) / 4; u += NWAVES * 64) ((LAS unsigned*)(ldsl + LDSCTL_OFF))[u] = 0u;
    __syncthreads();
    XcdBarrier bar = xcd_barrier_post((unsigned*)(ctl + CW_BAR), MISC + 8);
#define GRID_BAR() xcd_barrier(bar)

    if (PHMASK & (1 << 0)) {
        PHASE_PTRS();
        LAS float* scr = (LAS float*)(ldsl + RING_OFF + wave * 16384);
        constexpr int I1 = (DM / 64) * (NP1 / 32), I2 = (256 / 64) * (768 / 32), I2B = (128 / 64) * (1024 / 32), I3 = (512 / 64) * (DM / 32), I4 = (DM / 64) * (DM / 32),
                      I5 = (DM / 64) * (DFF2 / 32), I6 = (DFF / 64) * (DM / 32);
        constexpr int NITEMS = I1 + I2 + I2B + 2 * I3 + I4 + I5 + I6;
        for (int it = gw; it < NITEMS; it += NGW) {
            int r = it;
            if (r < I1) { p0_transpose_item(w_in, DM, IN_COLS, NP1, Bt1, nullptr, scr, r, lane, MapIn()); continue; } r -= I1;
            if (r < I2) { p0_transpose_item(w_uq, 256, 768, 768, Bt2, q_norm_g, scr, r, lane, MapUq()); continue; } r -= I2;
            if (r < I2B) { p0_transpose_item(w_ukv, 128, 1024, 1024, Bt2b, kv_norm_g, scr, r, lane, MapUkv()); continue; } r -= I2B;
            if (r < I3) { p0_transpose_item(w_bm, 512, DM, DM, Bt3a, nullptr, scr, r, lane, MapId()); continue; } r -= I3;
            if (r < I3) { p0_transpose_item(w_bl, 512, DM, DM, Bt3b, nullptr, scr, r, lane, MapId()); continue; } r -= I3;
            if (r < I4) { p0_transpose_item(w_out, DM, DM, DM, Bt4, nullptr, scr, r, lane, MapId()); continue; } r -= I4;
            if (r < I5) { p0_transpose_item(w_up, DM, DFF2, DFF2, Bt5, norm_ffn_g, scr, r, lane, MapId()); continue; } r -= I5;
            p0_transpose_item(w_down, DFF, DM, DM, Bt6, nullptr, scr, r, lane, MapId());
        }
        for (int m = gw; m < T; m += NGW) {
            const GAS f32x4* xr = (const GAS f32x4*)(x + (size_t)m * DM) + lane; const GAS f32x4* gr = (const GAS f32x4*)norm_attn_g + lane;
            f32x4 v[4]; float s = 0.f;
#pragma unroll
            for (int j = 0; j < 4; ++j) { v[j] = xr[64 * j]; s += (v[j].x * v[j].x + v[j].y * v[j].y) + (v[j].z * v[j].z + v[j].w * v[j].w); }
            const float rinv = 1.0f / sqrtf(wave_sum(s) * (1.f / DM) + EPS);
            GAS unsigned long long* o8 = (GAS unsigned long long*)(XN + (size_t)m * DM) + lane;
#pragma unroll
            for (int j = 0; j < 4; ++j) { const f32x4 gg = gr[64 * j];
                o8[64 * j] = (unsigned long long)pk2(v[j].x * rinv * gg.x, v[j].y * rinv * gg.y) | ((unsigned long long)pk2(v[j].z * rinv * gg.z, v[j].w * rinv * gg.w) << 32); }
        }
        for (int i = gt; i < 4 * T; i += NGT) ssq_cq[i] = 0.f;
        for (int i = gt; i < SEQ * 16; i += NGT) { const int pos = i >> 4, j = i & 15; float s, c; sincos_rev((float)pos * INV_FREQ[j], s, c); ropetab[i] = (f32x2){c, s}; }
        for (int i = gt; i < 8 * 128; i += NGT) { const int h = i >> 7, rel = i & 127;
            int bk = rel; if (rel >= 16) { bk = 16 + (int)(logf((float)rel / 16.0f) / logf(8.0f) * 16.0f); bk = bk > 31 ? 31 : bk; }
            BTAB[i] = (rel_bias[bk * 8 + h] - rel_bias[31 * 8 + h]) * LOG2E; }
    }
    GRID_BAR();
    DBG_DUMP(0);

    if (PHMASK & (1 << 1)) {
        PHASE_PTRS();
        pg8::Gemm g{XN, 0, Bt1, 0, DM, DM}; pg8::StaticOrder S; S.init(T, NP1, G, bx);
        pg8::EpiProj E{QA, (long)((WS_KA - WS_QA) / 2), CQ, CKV, KR, GATE, ssq_cq, ssq_ckv, b_gate, (const pg8::f32x2*)ropetab};
        pg8::gemm_phase<pg8::EpiProj, pg8::StaticOrder, true, true>(ldsl + RING_OFF, g, S, E);
    }
    GRID_BAR();
    DBG_DUMP(1);

    if (PHMASK & (1 << 2)) {
        PHASE_PTRS();
        {   pg8::Gemm g{CQ, 0, Bt2, 0, 256, 256}; pg8::StaticOrder S; S.init(T, 768, G, bx);
            pg8::EpiQup E{QM, ssq_cq, (const pg8::f32x2*)ropetab};
            pg8::gemm_phase<pg8::EpiQup, pg8::StaticOrder, true, true>(ldsl + RING_OFF, g, S, E); }
        {   pg8::Gemm g{CKV, 0, Bt2b, 0, 128, 128}; pg8::StaticOrder S; S.init(T, 1024, G, bx);
            pg8::EpiKVup E{KN, (long)((WS_VM - WS_KN) / 2), ssq_ckv};
            pg8::gemm_phase<pg8::EpiKVup, pg8::StaticOrder, true, true>(ldsl + RING_OFF, g, S, E); }
        __syncthreads();
        LAS float* red = (LAS float*)(ldsl + RING_OFF);
        for (int it = vcu; it < BATCH * 32; it += G) {
            const int c = tid & 63, rg = tid >> 6; const bf16* src = KA + ((size_t)it * 256 + rg * 32) * 512 + c * 8;
            float s[8];
#pragma unroll
            for (int i = 0; i < 8; ++i) s[i] = 0.f;
#pragma unroll 4
            for (int r = 0; r < 32; ++r) { const v4u w = *(const v4u*)(src + (size_t)r * 512); f32x4 a, b2; pg8::unpack8(w, a, b2);
                s[0] += a[0]; s[1] += a[1]; s[2] += a[2]; s[3] += a[3]; s[4] += b2[0]; s[5] += b2[1]; s[6] += b2[2]; s[7] += b2[3]; }
#pragma unroll
            for (int i = 0; i < 8; ++i) red[rg * 512 + c * 8 + i] = s[i];
            __syncthreads();
            { float t = 0.f;
#pragma unroll
              for (int r = 0; r < 8; ++r) t += red[r * 512 + tid];
              const int b = it >> 5, blk = it & 31, h = tid >> 6, d = tid & 63;
              KMEAN[((size_t)(b * 8 + h) * 32 + blk) * 64 + d] = (bf16)f2bf(t * (1.0f / 256.0f)); }
            __syncthreads();
        }
    }
    GRID_BAR();
    DBG_DUMP(2);

    if (PHMASK & (1 << 3)) {
        PHASE_PTRS();
        att::Args am{QA, KA, nullptr, VA, YA, KMEAN, BTAB, nullptr, 512};
        for (int it = vcu; it < 512; it += G) { const int bh = it >> 4, s = it & 15;
            att::attn_unit<64, true>(am, bh >> 3, bh & 7, 31 - s, (char*)lds + RING_OFF);
            att::attn_unit<64, true>(am, bh >> 3, bh & 7, s, (char*)lds + RING_OFF); }
        att::Args al{QM, KN, KR, VM, YB, nullptr, nullptr, (const float*)ropetab, 768};
        for (int it = vcu; it < 512; it += G) { const int bh = it >> 4, s = it & 15;
            att::attn_unit<96, false>(al, bh >> 3, bh & 7, 31 - s, (char*)lds + RING_OFF);
            att::attn_unit<96, false>(al, bh >> 3, bh & 7, s, (char*)lds + RING_OFF); }
    }
    GRID_BAR();
    DBG_DUMP(3);

    if (PHMASK & (1 << 4)) {
        PHASE_PTRS();
        pg8::Gemm g{YA, (long)((WS_YB - WS_YA) / 2), Bt3a, (long)((WS_BT3B - WS_BT3A) / 2), 512, 512}; pg8::StaticOrder S; S.init(T, DM, G, bx, 2);
        pg8::EpiMix E{GATE, MIX};
        pg8::gemm_phase<pg8::EpiMix, pg8::StaticOrder, true, true>(ldsl + RING_OFF, g, S, E);
    }
    GRID_BAR();
    DBG_DUMP(4);

    if (PHMASK & (1 << 5)) {
        PHASE_PTRS();
        pg8::Gemm g{MIX, 0, Bt4, 0, DM, DM}; pg8::StaticOrder S; S.init(T, DM, G, bx);
        pg8::EpiOut E{x, out, H1B, ssq_h1};
        pg8::gemm_phase<pg8::EpiOut, pg8::StaticOrder, true, true>(ldsl + RING_OFF, g, S, E);
    }
    GRID_BAR();
    DBG_DUMP(5);

    if (PHMASK & (1 << 6)) {
        PHASE_PTRS();
        pg8::Gemm g{H1B, 0, Bt5, 0, DM, DM}; pg8::StaticOrder S; S.init(T, DFF2, G, bx);
        pg8::EpiUp E{U, UH, ssq_h1};
        pg8::gemm_phase<pg8::EpiUp, pg8::StaticOrder, true, true>(ldsl + RING_OFF, g, S, E);
    }
    GRID_BAR();
    DBG_DUMP(6);

    if (PHMASK & (1 << 7)) {
        PHASE_PTRS();
        constexpr int NCH = DFF / 8;
        for (int it = gt; it < (T / 32) * NCH; it += NGT) {
            const int seg = it / NCH, ch = it % NCH, c = ch * 8; const int row0 = seg * 32;
            float wg[3][8], wv[3][8], bg[8], bvv[8];
#pragma unroll
            for (int j = 0; j < 3; ++j)
#pragma unroll
                for (int i = 0; i < 8; ++i) { wg[j][i] = conv_w[j * DFF2 + c + i]; wv[j][i] = conv_w[j * DFF2 + DFF + c + i]; }
#pragma unroll
            for (int i = 0; i < 8; ++i) { bg[i] = conv_b[c + i]; bvv[i] = conv_b[DFF + c + i]; }
            f32x4 g2a, g2b, g1a, g1b, v2a, v2b, v1a, v1b;
            if ((row0 & (SEQ - 1)) == 0) { g2a = g2b = g1a = g1b = v2a = v2b = v1a = v1b = (f32x4){0.f, 0.f, 0.f, 0.f}; }
            else { const bf16* hp = UH + (size_t)(seg - 1) * 2 * DFF2 + c;
                pg8::unpack8(*(const v4u*)hp, g2a, g2b); pg8::unpack8(*(const v4u*)(hp + DFF2), g1a, g1b);
                pg8::unpack8(*(const v4u*)(hp + DFF), v2a, v2b); pg8::unpack8(*(const v4u*)(hp + DFF2 + DFF), v1a, v1b); }
            bf16* up = U + (size_t)row0 * DFF2 + c;
#pragma unroll 2
            for (int r = 0; r < 32; ++r) {
                f32x4 g0a, g0b, v0a, v0b; pg8::unpack8(*(const v4u*)(up + (size_t)r * DFF2), g0a, g0b); pg8::unpack8(*(const v4u*)(up + (size_t)r * DFF2 + DFF), v0a, v0b);
                f32x4 oa, ob;
#pragma unroll
                for (int i = 0; i < 4; ++i) {
                    const float ga = bg[i] + wg[2][i] * g0a[i] + wg[1][i] * g1a[i] + wg[0][i] * g2a[i];
                    const float va = bvv[i] + wv[2][i] * v0a[i] + wv[1][i] * v1a[i] + wv[0][i] * v2a[i];
                    const float gb = bg[4 + i] + wg[2][4 + i] * g0b[i] + wg[1][4 + i] * g1b[i] + wg[0][4 + i] * g2b[i];
                    const float vb = bvv[4 + i] + wv[2][4 + i] * v0b[i] + wv[1][4 + i] * v1b[i] + wv[0][4 + i] * v2b[i];
                    oa[i] = ga * pg8::sigmoidf_(ga) * va; ob[i] = gb * pg8::sigmoidf_(gb) * vb; }
                *(v4u*)(up + (size_t)r * DFF2) = pg8::pack8(oa, ob);
                g2a = g1a; g2b = g1b; g1a = g0a; g1b = g0b; v2a = v1a; v2b = v1b; v1a = v0a; v1b = v0b;
            }
        }
    }
    GRID_BAR();
    DBG_DUMP(7);

    if (PHMASK & (1 << 8)) {
        PHASE_PTRS();
        pg8::Gemm g{U, 0, Bt6, 0, DFF2, DFF}; pg8::StaticOrder S; S.init(T, DM, G, bx);
        pg8::EpiDown E{out, ssq_h2};
        pg8::gemm_phase<pg8::EpiDown, pg8::StaticOrder, true, true>(ldsl + RING_OFF, g, S, E);
    }
    GRID_BAR();
    DBG_DUMP(8);

    if (PHMASK & (1 << 9)) {
        PHASE_PTRS();
        const bool bad = (__hip_atomic_load(ctl + CW_BAR + XB_TMO, RLX_AGENT) != 0u);
        for (int m = gw; m < T; m += NGW) {
            GAS f32x4* xr = (GAS f32x4*)(out + (size_t)m * DM) + lane; const GAS f32x4* gr = (const GAS f32x4*)norm_final_g + lane;
            const float rinv = 1.0f / sqrtf(ssq_h2[m] * (1.f / DM) + EPS);
#pragma unroll
            for (int j = 0; j < 4; ++j) { f32x4 v = xr[64 * j]; const f32x4 gg = gr[64 * j]; v = v * rinv * gg; if (bad) v = (f32x4){__builtin_nanf(""), __builtin_nanf(""), __builtin_nanf(""), __builtin_nanf("")}; xr[64 * j] = v; }
        }
    }
}

extern "C" void kernel_launch(void* const* d_in, const int* in_sizes, int n_in, void* d_out, int out_size, void* d_ws, size_t ws_size, hipStream_t stream) {
    static int grid = 0;
    if (grid == 0) {
        if (n_in != 18 || in_sizes[0] != T * DM || out_size != T * DM || ws_size < WS_END) {
            fprintf(stderr, "kernel_launch: shape/workspace mismatch (n_in %d, in0 %d, out %d, ws %zu need %zu); nothing launched\n", n_in, n_in > 0 ? in_sizes[0] : -1, out_size, ws_size, (size_t)WS_END); grid = -1; return; }
        int dev = 0, cus = 0, per_cu = 0;
        if (hipGetDevice(&dev) != hipSuccess || hipDeviceGetAttribute(&cus, hipDeviceAttributeMultiprocessorCount, dev) != hipSuccess) { fprintf(stderr, "kernel_launch: device query failed\n"); grid = -1; return; }
        if (hipFuncSetAttribute((const void*)hybrid_fwd, hipFuncAttributeMaxDynamicSharedMemorySize, LDS_BYTES) != hipSuccess) { fprintf(stderr, "kernel_launch: hipFuncSetAttribute failed\n"); grid = -1; return; }
        if (hipOccupancyMaxActiveBlocksPerMultiprocessor(&per_cu, (const void*)hybrid_fwd, NWAVES * 64, LDS_BYTES) != hipSuccess || per_cu < 1)
            fprintf(stderr, "kernel_launch: note: occupancy query reports %d workgroups per CU\n", per_cu);
        (void)hipGetLastError();
        grid = cus;
    }
    if (grid < 0) return;
    if (hipMemsetAsync((char*)d_ws + WS_CTL, 0, CTL_ZERO_BYTES, stream) != hipSuccess) { fprintf(stderr, "kernel_launch: memset failed\n"); return; }
    KArgs a{};
    for (int i = 0; i < 18; ++i) a.in[i] = (const float*)d_in[i];
    a.out = (float*)d_out; a.ws = (unsigned char*)d_ws;
    hipLaunchKernelGGL(hybrid_fwd, dim3(grid), dim3(NWAVES * 64), LDS_BYTES, stream, a);
    const hipError_t le = hipPeekAtLastError();
    if (le != hipSuccess) fprintf(stderr, "kernel_launch: launch failed: %s\n", hipGetErrorName(le));
}
```

```cpp
#include <hip/hip_runtime.h>
#include <cstdio>
#include <cstdint>

constexpr int BATCH = 4, SEQ = 8192, DM = 1024, T = BATCH * SEQ;
constexpr int IN_COLS = 4000, NP1 = 4096;
constexpr int DFF = 2816, DFF2 = 5632;
constexpr float EPS = 1e-6f;
constexpr float LOG2E = 1.4426950408889634f;
constexpr float C2_MOBA = 0.125f * LOG2E;
constexpr float C2_MLA = 0.10206207261596577f * LOG2E;

namespace pg8 {
#define PG8_LAS __attribute__((address_space(3)))
typedef unsigned short bf16_t;
typedef short bf16x8 __attribute__((ext_vector_type(8)));
typedef float f32x4 __attribute__((ext_vector_type(4)));
typedef unsigned u32x4 __attribute__((ext_vector_type(4)));
constexpr int BM = 256, BK = 64, HALF = 128, HTB = HALF * BK * 2  , STAGE_BYTES = 8 * HTB, NXCD = 8, WGM = 8;

__host__ __device__ __forceinline__ int lds_byte(int r, int c) { const int st = (r >> 4) * 2 + (c >> 5), rr = r & 15, cc = c & 31, ob = rr * 64 + cc * 2; return st * 1024 + (ob ^ (((ob >> 9) & 1) << 5)); }
__host__ __device__ __forceinline__ void stage_rc(int b, int& R, int& C) { const int st = b / 1024, sb = b % 1024, swz = sb ^ (((sb >> 9) & 1) << 5); R = (st >> 1) * 16 + swz / 64; C = (st & 1) * 32 + (swz % 64) / 2; }
__host__ __device__ __forceinline__ int perm32(int rho) { const int n = rho >> 4, i = rho & 15; return 8 * (i >> 2) + 4 * n + (i & 3); }

struct Unit { int pm, pn, z; };
struct Gemm { const bf16_t* A0; long dA; const bf16_t* B0; long dB; int lda, K; };

struct StaticOrder {
    int nM, nN, nwg, G, c, zrep;
    __host__ __device__ void init(int M, int N, int G_, int c_, int zrep_ = 1) { nM = M / BM; nN = N / BM; nwg = nM * nN; G = G_; c = c_; zrep = zrep_; }
    __host__ __device__ bool next(int ii, Unit& u) const {
        const int i = ii / zrep; u.z = ii % zrep;
        const long L = (long)i * G + c; if (L >= nwg) return false;
        int wgid = (int)L; { const int q = nwg / NXCD, r = nwg % NXCD, xcd = wgid % NXCD, off = wgid / NXCD; wgid = (xcd < r ? xcd * (q + 1) : r * (q + 1) + (xcd - r) * q) + off; }
        const int nig = WGM * nN, gid = wgid / nig, fm = gid * WGM, gsz = (nM - fm) < WGM ? (nM - fm) : WGM;
        u.pm = fm + ((wgid % nig) % gsz); u.pn = (wgid % nig) / gsz; return true;
    }
};

typedef float f32x2_t __attribute__((ext_vector_type(2))); typedef __bf16 bf16x2_t __attribute__((ext_vector_type(2)));
__device__ __forceinline__ unsigned cvt_pk_bf16(float lo, float hi) { f32x2_t v = {lo, hi}; bf16x2_t b = __builtin_convertvector(v, bf16x2_t); return __builtin_bit_cast(unsigned, b); }
__device__ __forceinline__ u32x4 pack8(f32x4 v0, f32x4 v1) { u32x4 w; w.x = cvt_pk_bf16(v0[0], v0[1]); w.y = cvt_pk_bf16(v0[2], v0[3]); w.z = cvt_pk_bf16(v1[0], v1[1]); w.w = cvt_pk_bf16(v1[2], v1[3]); return w; }
__device__ __forceinline__ float bf2f(unsigned short h) { return __uint_as_float((unsigned)h << 16); }
__device__ __forceinline__ void unpack8(u32x4 w, f32x4& a, f32x4& b) {
    a[0] = __uint_as_float(w.x << 16); a[1] = __uint_as_float(w.x & 0xffff0000u); a[2] = __uint_as_float(w.y << 16); a[3] = __uint_as_float(w.y & 0xffff0000u);
    b[0] = __uint_as_float(w.z << 16); b[1] = __uint_as_float(w.z & 0xffff0000u); b[2] = __uint_as_float(w.w << 16); b[3] = __uint_as_float(w.w & 0xffff0000u);
}

template <class Epi, class Sched, bool ALIGN_EPI = false, bool SP2 = false>
__device__ __forceinline__ void gemm_phase(PG8_LAS unsigned char* lds, const Gemm g, const Sched& S, const Epi& E) {
    int tid_ = threadIdx.x; asm volatile("" : "+v"(tid_));
    const int tid = tid_, wid = __builtin_amdgcn_readfirstlane(tid >> 6), lane = tid & 63, wr = wid >> 2, wc = wid & 3, fr = lane & 15, fq = lane >> 4;
    const int K = g.K, nt = K / BK, lda = g.lda;
    unsigned voffA[2], voffB[2];
#pragma unroll
    for (int i = 0; i < 2; ++i) { int R, C; stage_rc(tid * 16 + i * 8192, R, C); const int Rb = (R & ~31) + perm32(R & 31);
        voffA[i] = (unsigned)(R * lda + C) * 2u; voffB[i] = (unsigned)(Rb * K + C) * 2u; }
    const size_t kstep = (size_t)(BK * 2);
    const size_t hstepA = (size_t)HALF * lda * 2, hstepB = (size_t)HALF * K * 2;
    const size_t tstepA = 2 * hstepA, tstepB = 2 * hstepB;
    const unsigned ldsw = (unsigned)wid * 1024u;
    const int aoff = lds_byte(wr * 64 + fr, fq * 8), boff = lds_byte(wc * 32 + fr, fq * 8);
#define PG8_SA(b, h) (((b) * 2 + (h)) * HTB)
#define PG8_SB(b, h) ((4 + (b) * 2 + (h)) * HTB)
#define PG8_STAGE(bufoff, gbase, voff) do { _Pragma("unroll") for (int _i = 0; _i < 2; ++_i) \
        __builtin_amdgcn_global_load_lds((const unsigned*)((const char*)(gbase) + (voff)[_i]), (PG8_LAS unsigned*)(lds + (bufoff) + ldsw + _i * 8192), 16, 0, 0); } while (0)
#define PG8_LDA(dst, b, h) do { _Pragma("unroll") for (int m = 0; m < 4; ++m) _Pragma("unroll") for (int k = 0; k < 2; ++k) dst[m][k] = *(const PG8_LAS bf16x8*)(lds + PG8_SA(b, h) + aoff + m * 2048 + k * 1024); } while (0)
#define PG8_LDB(dst, b, h) do { _Pragma("unroll") for (int n = 0; n < 2; ++n) _Pragma("unroll") for (int k = 0; k < 2; ++k) dst[n][k] = *(const PG8_LAS bf16x8*)(lds + PG8_SB(b, h) + boff + n * 2048 + k * 1024); } while (0)
#define PG8_MMA(ai, bj, At, Bt) do { __builtin_amdgcn_s_setprio(1); _Pragma("unroll") for (int m = 0; m < 4; ++m) _Pragma("unroll") for (int n = 0; n < 2; ++n) _Pragma("unroll") for (int k = 0; k < 2; ++k) \
        acc[ai][bj][m][n] = __builtin_amdgcn_mfma_f32_16x16x32_bf16(Bt[n][k], At[m][k], acc[ai][bj][m][n], 0, 0, 0); __builtin_amdgcn_s_setprio(0); } while (0)
#define PG8_WAIT_V(n) asm volatile("s_waitcnt vmcnt(" #n ")" ::: "memory")
#define PG8_WAIT_L(n) asm volatile("s_waitcnt lgkmcnt(" #n ")" ::: "memory")
#define PG8_BAR __builtin_amdgcn_s_barrier()
#define PG8_SCHED __builtin_amdgcn_sched_barrier(0)
#define PG8_BASEA(u) ((const char*)(g.A0 + (long)(u).z * g.dA) + (size_t)(u).pm * tstepA)
#define PG8_BASEB(u) ((const char*)(g.B0 + (long)(u).z * g.dB) + (size_t)(u).pn * tstepB)
    Unit cur, nxt; int ui = 0;
    if (!S.next(0, cur)) return;
    f32x4 acc[2][2][4][2];
#pragma unroll
    for (int a = 0; a < 2; ++a)
#pragma unroll
        for (int b = 0; b < 2; ++b)
#pragma unroll
            for (int m = 0; m < 4; ++m)
#pragma unroll
                for (int n = 0; n < 2; ++n) acc[a][b][m][n] = (f32x4){0.f, 0.f, 0.f, 0.f};
    bf16x8 At[4][2], B0[2][2], B1[2][2];
    const char* cA = PG8_BASEA(cur); const char* cB = PG8_BASEB(cur);
    if constexpr (SP2) {
        PG8_STAGE(PG8_SB(0, 0), cB, voffB); PG8_STAGE(PG8_SB(0, 1), cB + hstepB, voffB); PG8_STAGE(PG8_SA(0, 0), cA, voffA); PG8_STAGE(PG8_SA(0, 1), cA + hstepA, voffA);
        if (wr == 1) PG8_BAR;
        PG8_WAIT_V(2); PG8_BAR;
        PG8_STAGE(PG8_SB(1, 0), cB + kstep, voffB); PG8_STAGE(PG8_SA(1, 0), cA + kstep, voffA); PG8_STAGE(PG8_SB(1, 1), cB + hstepB + kstep, voffB);
        PG8_WAIT_V(6); PG8_BAR;
    } else {
        PG8_STAGE(PG8_SB(0, 0), cB, voffB); PG8_STAGE(PG8_SA(0, 0), cA, voffA); PG8_STAGE(PG8_SB(0, 1), cB + hstepB, voffB); PG8_STAGE(PG8_SA(0, 1), cA + hstepA, voffA);
        if (wr == 1) PG8_BAR;
        PG8_WAIT_V(4); PG8_BAR;
        PG8_STAGE(PG8_SB(1, 0), cB + kstep, voffB); PG8_STAGE(PG8_SA(1, 0), cA + kstep, voffA); PG8_STAGE(PG8_SB(1, 1), cB + hstepB + kstep, voffB);
        PG8_WAIT_V(6); PG8_BAR;
    }
    for (;;) {
        const bool has_next = S.next(ui + 1, nxt);
        const char* nA = has_next ? PG8_BASEA(nxt) : cA; const char* nB = has_next ? PG8_BASEB(nxt) : cB;
        for (int t = 0; t < nt; t += 2) {
            const bool last = (t == nt - 2);
            const char* a1 = cA + (size_t)(t + 1) * kstep;
            const char* a2 = last ? nA : cA + (size_t)(t + 2) * kstep; const char* b2 = last ? nB : cB + (size_t)(t + 2) * kstep;
            const char* a3 = a2 + kstep; const char* b3 = b2 + kstep;
            if constexpr (SP2) {
            PG8_LDB(B0, 0, 0); PG8_LDB(B1, 0, 1); PG8_SCHED; PG8_LDA(At, 0, 0); PG8_STAGE(PG8_SA(1, 1), a1 + hstepA, voffA);
            PG8_WAIT_V(8); PG8_WAIT_L(0); PG8_BAR; PG8_MMA(0, 0, At, B0); PG8_MMA(0, 1, At, B1); PG8_BAR; PG8_SCHED;
            PG8_LDA(At, 0, 1); PG8_STAGE(PG8_SB(0, 0), b2, voffB); PG8_STAGE(PG8_SB(0, 1), b2 + hstepB, voffB); PG8_STAGE(PG8_SA(0, 0), a2, voffA);
            PG8_WAIT_V(8); PG8_WAIT_L(0); PG8_BAR; PG8_MMA(1, 0, At, B0); PG8_MMA(1, 1, At, B1); PG8_BAR; PG8_SCHED;
            PG8_LDB(B0, 1, 0); PG8_LDB(B1, 1, 1); PG8_SCHED; PG8_LDA(At, 1, 0); PG8_STAGE(PG8_SA(0, 1), a2 + hstepA, voffA);
            PG8_WAIT_V(8); PG8_WAIT_L(0); PG8_BAR; PG8_MMA(0, 0, At, B0); PG8_MMA(0, 1, At, B1); PG8_BAR; PG8_SCHED;
            PG8_LDA(At, 1, 1); PG8_STAGE(PG8_SB(1, 0), b3, voffB); PG8_STAGE(PG8_SB(1, 1), b3 + hstepB, voffB); PG8_STAGE(PG8_SA(1, 0), a3, voffA);
            PG8_WAIT_V(8); PG8_WAIT_L(0); PG8_BAR; PG8_MMA(1, 0, At, B0); PG8_MMA(1, 1, At, B1); PG8_BAR; PG8_SCHED;
            } else {
            PG8_LDB(B0, 0, 0); PG8_SCHED; PG8_LDA(At, 0, 0); PG8_STAGE(PG8_SA(1, 1), a1 + hstepA, voffA);
            PG8_WAIT_L(8); PG8_BAR; PG8_WAIT_L(0); PG8_MMA(0, 0, At, B0); PG8_BAR; PG8_SCHED;
            PG8_LDB(B1, 0, 1); PG8_STAGE(PG8_SB(0, 0), b2, voffB);
            PG8_BAR; PG8_WAIT_L(0); PG8_MMA(0, 1, At, B1); PG8_BAR;
            PG8_LDA(At, 0, 1); PG8_STAGE(PG8_SA(0, 0), a2, voffA);
            PG8_BAR; PG8_WAIT_L(0); PG8_MMA(1, 0, At, B0); PG8_BAR; PG8_SCHED;
            PG8_STAGE(PG8_SB(0, 1), b2 + hstepB, voffB);
            PG8_WAIT_V(6); PG8_BAR; PG8_MMA(1, 1, At, B1); PG8_BAR;
            PG8_LDB(B0, 1, 0); PG8_SCHED; PG8_LDA(At, 1, 0); PG8_STAGE(PG8_SA(0, 1), a2 + hstepA, voffA);
            PG8_WAIT_L(8); PG8_BAR; PG8_WAIT_L(0); PG8_MMA(0, 0, At, B0); PG8_BAR; PG8_SCHED;
            PG8_LDB(B1, 1, 1); PG8_STAGE(PG8_SB(1, 0), b3, voffB);
            PG8_BAR; PG8_WAIT_L(0); PG8_MMA(0, 1, At, B1); PG8_BAR;
            PG8_LDA(At, 1, 1); PG8_STAGE(PG8_SA(1, 0), a3, voffA);
            PG8_BAR; PG8_WAIT_L(0); PG8_MMA(1, 0, At, B0); PG8_BAR; PG8_SCHED;
            PG8_STAGE(PG8_SB(1, 1), b3 + hstepB, voffB);
            PG8_WAIT_V(6); PG8_BAR; PG8_MMA(1, 1, At, B1); PG8_BAR;
            }
        }
        if constexpr (ALIGN_EPI) { if (wr == 0) PG8_BAR; }
        E(acc, cur, wr, wc, fr, fq);
        if (!has_next) break;
        bool keep_acc = false;
        if constexpr (Epi::HAS_KEEP) keep_acc = E.keep(cur);
        if (!keep_acc)
#pragma unroll
        for (int a = 0; a < 2; ++a)
#pragma unroll
            for (int b = 0; b < 2; ++b)
#pragma unroll
                for (int m = 0; m < 4; ++m)
#pragma unroll
                    for (int n = 0; n < 2; ++n) acc[a][b][m][n] = (f32x4){0.f, 0.f, 0.f, 0.f};
        cur = nxt; cA = nA; cB = nB; ++ui;
        if constexpr (ALIGN_EPI) { if (wr == 1) PG8_BAR; }
    }
    PG8_WAIT_V(0);
    if constexpr (!ALIGN_EPI) { if (wr == 0) PG8_BAR; }
    PG8_BAR;
#undef PG8_SA
#undef PG8_SB
#undef PG8_STAGE
#undef PG8_LDA
#undef PG8_LDB
#undef PG8_MMA
#undef PG8_WAIT_V
#undef PG8_WAIT_L
#undef PG8_BAR
#undef PG8_SCHED
#undef PG8_BASEA
#undef PG8_BASEB
}

__device__ __forceinline__ int opq(int x) { asm volatile("" : "+v"(x)); return x; }
typedef float f32x2 __attribute__((ext_vector_type(2)));
__device__ __forceinline__ float sigmoidf_(float z) { return __builtin_amdgcn_rcpf(1.0f + __builtin_amdgcn_exp2f(-z * LOG2E)); }
__device__ __forceinline__ float sumsq8(f32x4 a, f32x4 b) { return (a[0] * a[0] + a[1] * a[1]) + (a[2] * a[2] + a[3] * a[3]) + (b[0] * b[0] + b[1] * b[1]) + (b[2] * b[2] + b[3] * b[3]); }
__device__ __forceinline__ void rope8(f32x4& v0, f32x4& v1, const f32x2* cs) {
    const f32x4 c01 = *(const f32x4*)cs, c23 = *(const f32x4*)(cs + 2);
    f32x4 o0, o1;
    o0[0] = v0[0] * c01[0] - v0[1] * c01[1]; o0[1] = v0[1] * c01[0] + v0[0] * c01[1];
    o0[2] = v0[2] * c01[2] - v0[3] * c01[3]; o0[3] = v0[3] * c01[2] + v0[2] * c01[3];
    o1[0] = v1[0] * c23[0] - v1[1] * c23[1]; o1[1] = v1[1] * c23[0] + v1[0] * c23[1];
    o1[2] = v1[2] * c23[2] - v1[3] * c23[3]; o1[3] = v1[3] * c23[2] + v1[2] * c23[3];
    v0 = o0; v1 = o1;
}

struct EpiProj {
    static constexpr bool HAS_KEEP = false;
    bf16_t *QA; long dQKV; bf16_t *CQ, *CKV, *KR, *GATE; float *ssq_cq, *ssq_ckv; const float* b_gate; const f32x2* ropetab;
    __device__ __forceinline__ void operator()(f32x4 (&acc)[2][2][4][2], const Unit& u, int wr, int wc, int fr, int fq) const {
        const int pn = u.pn, row0 = u.pm * BM + wr * 64 + fr, cw = wc * 32 + 8 * fq;
        if (pn < 6) {
            bf16_t* base = QA + (long)(pn >> 1) * dQKV; const float sc = pn < 2 ? C2_MOBA : 1.0f; const int colt = (pn & 1) * 256 + cw;
#pragma unroll
            for (int ai = 0; ai < 2; ++ai)
#pragma unroll
                for (int m = 0; m < 4; ++m) { bf16_t* rowp = base + (size_t)opq(row0 + ai * HALF + m * 16) * 512 + colt;
#pragma unroll
                    for (int bj = 0; bj < 2; ++bj) *(u32x4*)(rowp + bj * HALF) = pack8(acc[ai][bj][m][0] * sc, acc[ai][bj][m][1] * sc); }
        } else if (pn == 6) {
#pragma unroll
            for (int ai = 0; ai < 2; ++ai)
#pragma unroll
                for (int m = 0; m < 4; ++m) { const int row = opq(row0 + ai * HALF + m * 16); bf16_t* rowp = CQ + (size_t)row * 256 + cw; float ss = 0.f;
#pragma unroll
                    for (int bj = 0; bj < 2; ++bj) { ss += sumsq8(acc[ai][bj][m][0], acc[ai][bj][m][1]); *(u32x4*)(rowp + bj * HALF) = pack8(acc[ai][bj][m][0], acc[ai][bj][m][1]); }
                    ss += __shfl_xor(ss, 16); ss += __shfl_xor(ss, 32);
                    if (fq == 0) atomicAdd(ssq_cq + row, ss); }
        } else if (pn == 7) {
#pragma unroll
            for (int ai = 0; ai < 2; ++ai)
#pragma unroll
                for (int m = 0; m < 4; ++m) { const int row = opq(row0 + ai * HALF + m * 16);
                    float ss = sumsq8(acc[ai][0][m][0], acc[ai][0][m][1]);
                    *(u32x4*)(CKV + (size_t)row * 128 + cw) = pack8(acc[ai][0][m][0], acc[ai][0][m][1]);
                    ss += __shfl_xor(ss, 16); ss += __shfl_xor(ss, 32);
                    if (fq == 0) atomicAdd(ssq_ckv + row, ss);
                    if (wc == 0) { f32x4 v0 = acc[ai][1][m][0], v1 = acc[ai][1][m][1];
                        rope8(v0, v1, ropetab + (size_t)(row & (SEQ - 1)) * 16 + 4 * fq);
                        *(u32x4*)(KR + (size_t)row * 32 + 8 * fq) = pack8(v0, v1); } }
        } else {
            const int gc = (pn - 8) * 256 + cw;
            f32x4 bv[2][2];
#pragma unroll
            for (int bj = 0; bj < 2; ++bj) { bv[bj][0] = *(const f32x4*)(b_gate + gc + bj * HALF); bv[bj][1] = *(const f32x4*)(b_gate + gc + bj * HALF + 4); }
#pragma unroll
            for (int ai = 0; ai < 2; ++ai)
#pragma unroll
                for (int m = 0; m < 4; ++m) { bf16_t* rowp = GATE + (size_t)opq(row0 + ai * HALF + m * 16) * 2048 + gc;
#pragma unroll
                    for (int bj = 0; bj < 2; ++bj) { f32x4 v0 = acc[ai][bj][m][0] + bv[bj][0], v1 = acc[ai][bj][m][1] + bv[bj][1];
#pragma unroll
                        for (int i = 0; i < 4; ++i) { v0[i] = sigmoidf_(v0[i]); v1[i] = sigmoidf_(v1[i]); }
                        *(u32x4*)(rowp + bj * HALF) = pack8(v0, v1); } }
        }
    }
};

struct EpiQup {
    static constexpr bool HAS_KEEP = false;
    bf16_t* QM; const float* ssq_cq; const f32x2* ropetab;
    __device__ __forceinline__ void operator()(f32x4 (&acc)[2][2][4][2], const Unit& u, int wr, int wc, int fr, int fq) const {
        const int row0 = u.pm * BM + wr * 64 + fr, c0 = u.pn * BM + wc * 32 + 8 * fq;
#pragma unroll
        for (int ai = 0; ai < 2; ++ai)
#pragma unroll
            for (int m = 0; m < 4; ++m) { const int row = opq(row0 + ai * HALF + m * 16);
                const float sc = __builtin_amdgcn_rsqf(ssq_cq[row] * (1.0f / 256.0f) + EPS) * C2_MLA;
#pragma unroll
                for (int bj = 0; bj < 2; ++bj) {
                    f32x4 v0 = acc[ai][bj][m][0] * sc, v1 = acc[ai][bj][m][1] * sc;
                    *(u32x4*)(QM + (size_t)row * 768 + c0 + bj * HALF) = pack8(v0, v1); asm volatile("" ::: "memory"); } }
    }
};
struct EpiKVup {
    static constexpr bool HAS_KEEP = false;
    bf16_t *KN; long dKV; const float* ssq_ckv;
    __device__ __forceinline__ void operator()(f32x4 (&acc)[2][2][4][2], const Unit& u, int wr, int wc, int fr, int fq) const {
        const int row0 = u.pm * BM + wr * 64 + fr, c0 = (u.pn & 1) * BM + wc * 32 + 8 * fq; bf16_t* base = KN + (long)(u.pn >> 1) * dKV;
#pragma unroll
        for (int ai = 0; ai < 2; ++ai)
#pragma unroll
            for (int m = 0; m < 4; ++m) { const int row = opq(row0 + ai * HALF + m * 16);
                const float sc = __builtin_amdgcn_rsqf(ssq_ckv[row] * (1.0f / 128.0f) + EPS);
#pragma unroll
                for (int bj = 0; bj < 2; ++bj) *(u32x4*)(base + (size_t)row * 512 + c0 + bj * HALF) = pack8(acc[ai][bj][m][0] * sc, acc[ai][bj][m][1] * sc); }
    }
};
struct EpiMix {
    static constexpr bool HAS_KEEP = true;
    const bf16_t* GATE; bf16_t* MIX;
    __device__ __forceinline__ bool keep(const Unit& u) const { return u.z == 0; }
    __device__ __forceinline__ void operator()(f32x4 (&acc)[2][2][4][2], const Unit& u, int wr, int wc, int fr, int fq) const {
        const int row0 = u.pm * BM + wr * 64 + fr, c0 = u.pn * BM + wc * 32 + 8 * fq;
#pragma unroll
        for (int ai = 0; ai < 2; ++ai)
#pragma unroll
            for (int m = 0; m < 4; ++m) { const int row = opq(row0 + ai * HALF + m * 16);
#pragma unroll
                for (int bj = 0; bj < 2; ++bj) { const int c = c0 + bj * HALF;
                    f32x4 ga, gb; unpack8(*(const u32x4*)(GATE + (size_t)row * 2048 + 1024 + c), ga, gb);
                    if (u.z == 0) { f32x4 ha, hb; unpack8(*(const u32x4*)(GATE + (size_t)row * 2048 + c), ha, hb);
#pragma unroll
                        for (int i = 0; i < 4; ++i) { ha[i] *= __builtin_amdgcn_rcpf(fmaxf(ga[i], 1e-30f)); hb[i] *= __builtin_amdgcn_rcpf(fmaxf(gb[i], 1e-30f)); }
                        acc[ai][bj][m][0] *= ha; acc[ai][bj][m][1] *= hb; }
                    else *(u32x4*)(MIX + (size_t)row * 1024 + c) = pack8(acc[ai][bj][m][0] * ga, acc[ai][bj][m][1] * gb);
                    asm volatile("" ::: "memory"); } }
    }
};
struct EpiOut {
    static constexpr bool HAS_KEEP = false;
    const float* X; float* OUT; bf16_t* H1B; float* ssq;
    __device__ __forceinline__ void operator()(f32x4 (&acc)[2][2][4][2], const Unit& u, int wr, int wc, int fr, int fq) const {
        const int row0 = u.pm * BM + wr * 64 + fr, c0 = u.pn * BM + wc * 32 + 8 * fq;
#pragma unroll
        for (int ai = 0; ai < 2; ++ai)
#pragma unroll
            for (int m = 0; m < 4; ++m) { const int row = opq(row0 + ai * HALF + m * 16); float ss = 0.f;
#pragma unroll
                for (int bj = 0; bj < 2; ++bj) { const size_t off = (size_t)row * 1024 + c0 + bj * HALF;
                    const f32x4 v0 = acc[ai][bj][m][0] + *(const f32x4*)(X + off), v1 = acc[ai][bj][m][1] + *(const f32x4*)(X + off + 4);
                    *(f32x4*)(OUT + off) = v0; *(f32x4*)(OUT + off + 4) = v1; *(u32x4*)(H1B + off) = pack8(v0, v1); ss += sumsq8(v0, v1); }
                ss += __shfl_xor(ss, 16); ss += __shfl_xor(ss, 32);
                if (fq == 0) atomicAdd(ssq + row, ss); }
    }
};
struct EpiUp {
    static constexpr bool HAS_KEEP = false;
    bf16_t *U, *UH; const float* ssq;
    __device__ __forceinline__ void operator()(f32x4 (&acc)[2][2][4][2], const Unit& u, int wr, int wc, int fr, int fq) const {
        const int row0 = u.pm * BM + wr * 64 + fr, c0 = u.pn * BM + wc * 32 + 8 * fq;
#pragma unroll
        for (int ai = 0; ai < 2; ++ai)
#pragma unroll
            for (int m = 0; m < 4; ++m) { const int row = opq(row0 + ai * HALF + m * 16);
                const float sc = __builtin_amdgcn_rsqf(ssq[row] * (1.0f / 1024.0f) + EPS);
                const bool halo = (row & 31) >= 30;
#pragma unroll
                for (int bj = 0; bj < 2; ++bj) { const u32x4 w = pack8(acc[ai][bj][m][0] * sc, acc[ai][bj][m][1] * sc);
                    *(u32x4*)(U + (size_t)row * DFF2 + c0 + bj * HALF) = w;
                    if (halo) *(u32x4*)(UH + ((size_t)(row >> 5) * 2 + (row & 1)) * DFF2 + c0 + bj * HALF) = w; } }
    }
};
struct EpiDown {
    static constexpr bool HAS_KEEP = false;
    float* OUT; float* ssq;
    __device__ __forceinline__ void operator()(f32x4 (&acc)[2][2][4][2], const Unit& u, int wr, int wc, int fr, int fq) const {
        const int row0 = u.pm * BM + wr * 64 + fr, c0 = u.pn * BM + wc * 32 + 8 * fq;
#pragma unroll
        for (int ai = 0; ai < 2; ++ai)
#pragma unroll
            for (int m = 0; m < 4; ++m) { const int row = opq(row0 + ai * HALF + m * 16); float ss = 0.f;
#pragma unroll
                for (int bj = 0; bj < 2; ++bj) { const size_t off = (size_t)row * 1024 + c0 + bj * HALF;
                    const f32x4 v0 = acc[ai][bj][m][0] + *(const f32x4*)(OUT + off), v1 = acc[ai][bj][m][1] + *(const f32x4*)(OUT + off + 4);
                    *(f32x4*)(OUT + off) = v0; *(f32x4*)(OUT + off + 4) = v1; ss += sumsq8(v0, v1); }
                ss += __shfl_xor(ss, 16); ss += __shfl_xor(ss, 32);
                if (fq == 0) atomicAdd(ssq + row, ss); }
    }
};
}

namespace att {
typedef unsigned short bf16;
typedef short bf16x8 __attribute__((ext_vector_type(8)));
typedef short s16x4 __attribute__((ext_vector_type(4)));
typedef float f32x16 __attribute__((ext_vector_type(16)));
typedef unsigned u32x4 __attribute__((ext_vector_type(4)));
#define SBAR() __builtin_amdgcn_sched_barrier(0)
constexpr int KVBLK = 64, QBLK = 32, QB = 256;
constexpr int V_BYTES = 8192, K_BYTES = 13312;
constexpr int OFF_V = 0, OFF_K = 2 * V_BYTES, OFF_WS = OFF_K + 2 * K_BYTES, OFF_BT = OFF_WS + 8 * 256, OFF_KM = OFF_BT + 512, LDS_BYTES = OFF_KM + 32 * 144;
constexpr float THR = 8.0f;
__device__ __forceinline__ int crow(int r, int hi) { return (r & 3) + 8 * (r >> 2) + 4 * hi; }
__device__ __forceinline__ unsigned cvtpk(float lo, float hi) { return pg8::cvt_pk_bf16(lo, hi); }
__device__ __forceinline__ int v_st(int k, int c) { const int kk = (k & ~0xC) | ((k & 4) << 1) | ((k & 8) >> 1); return ((kk >> 3) * 2 + (c >> 5)) * 512 + ((kk & 7) * 32 + (c & 31)) * 2; }
__device__ __forceinline__ int v_rd_base(int lane) { return ((lane & 3) << 3) | (((lane >> 2) & 3) << 6) | (((lane >> 4) & 1) << 5) | (((lane >> 5) & 1) << 8); }
constexpr int v_rd_off(int d0, int ks, int half) { return d0 * 512 + ks * 2048 + half * 1024; }
template <int OFF> __device__ __forceinline__ s16x4 tr_read(int vb) { s16x4 r; asm volatile("ds_read_b64_tr_b16 %0, %1 offset:%2" : "=&v"(r) : "v"(vb), "i"(OFF) : "memory"); return r; }

__device__ __forceinline__ void partialSM(f32x16& p0, f32x16& p1, float& m_reg, float& alpha) {
    float pmax = p0[0];
#pragma unroll
    for (int r = 1; r < 16; ++r) pmax = fmaxf(pmax, p0[r]);
#pragma unroll
    for (int r = 0; r < 16; ++r) pmax = fmaxf(pmax, p1[r]);
    { auto rr = __builtin_amdgcn_permlane32_swap(__float_as_uint(pmax), __float_as_uint(pmax), false, false); pmax = fmaxf(__uint_as_float(rr[0]), __uint_as_float(rr[1])); }
    float mn;
    if (__builtin_expect(__all(pmax - m_reg <= THR), 1)) { mn = m_reg; alpha = 1.f; }
    else { mn = fmaxf(m_reg, pmax); alpha = __builtin_amdgcn_exp2f(m_reg - mn); m_reg = mn; }
#pragma unroll
    for (int r = 0; r < 16; ++r) { p0[r] -= mn; p1[r] -= mn; }
#pragma unroll
    for (int r = 0; r < 16; ++r) p0[r] = __builtin_amdgcn_exp2f(p0[r]);
}
__device__ __forceinline__ void finishSM(f32x16& p0, f32x16& p1, float alpha, float& l_reg, bf16x8& pa0, bf16x8& pa1, bf16x8& pa2, bf16x8& pa3) {
#pragma unroll
    for (int r = 0; r < 16; ++r) p1[r] = __builtin_amdgcn_exp2f(p1[r]);
    float ps = 0;
#pragma unroll
    for (int r = 0; r < 16; ++r) ps += p0[r];
#pragma unroll
    for (int r = 0; r < 16; ++r) ps += p1[r];
    { auto rr = __builtin_amdgcn_permlane32_swap(__float_as_uint(ps), __float_as_uint(ps), false, false); ps = __uint_as_float(rr[0]) + __uint_as_float(rr[1]); }
    l_reg = l_reg * alpha + ps;
#define PK4(P, BASE, OUT) do { unsigned a0 = cvtpk(P[BASE + 0], P[BASE + 1]), a1 = cvtpk(P[BASE + 2], P[BASE + 3]);   \
    unsigned b0 = cvtpk(P[BASE + 4], P[BASE + 5]), b1 = cvtpk(P[BASE + 6], P[BASE + 7]);                              \
    auto r0 = __builtin_amdgcn_permlane32_swap(a0, b0, false, false); auto r1 = __builtin_amdgcn_permlane32_swap(a1, b1, false, false); \
    u32x4 w = {r0[0], r1[0], r0[1], r1[1]}; OUT = *reinterpret_cast<bf16x8*>(&w); } while (0)
    PK4(p0, 0, pa0); PK4(p0, 8, pa1); PK4(p1, 0, pa2); PK4(p1, 8, pa3);
#undef PK4
}
template <int D0> __device__ __forceinline__ void pv_one(f32x16& od, int vb, bf16x8 pa0, bf16x8 pa1, bf16x8 pa2, bf16x8 pa3) {
    const s16x4 l0 = tr_read<v_rd_off(D0, 0, 0)>(vb), h0 = tr_read<v_rd_off(D0, 0, 1)>(vb), l1 = tr_read<v_rd_off(D0, 1, 0)>(vb), h1 = tr_read<v_rd_off(D0, 1, 1)>(vb);
    const s16x4 l2 = tr_read<v_rd_off(D0, 2, 0)>(vb), h2 = tr_read<v_rd_off(D0, 2, 1)>(vb), l3 = tr_read<v_rd_off(D0, 3, 0)>(vb), h3 = tr_read<v_rd_off(D0, 3, 1)>(vb);
    asm volatile("s_waitcnt lgkmcnt(0)" ::: "memory"); SBAR();
#define PK(L, H) (bf16x8){L[0], L[1], L[2], L[3], H[0], H[1], H[2], H[3]}
    od = __builtin_amdgcn_mfma_f32_32x32x16_bf16(pa0, PK(l0, h0), od, 0, 0, 0);
    od = __builtin_amdgcn_mfma_f32_32x32x16_bf16(pa1, PK(l1, h1), od, 0, 0, 0);
    od = __builtin_amdgcn_mfma_f32_32x32x16_bf16(pa2, PK(l2, h2), od, 0, 0, 0);
    od = __builtin_amdgcn_mfma_f32_32x32x16_bf16(pa3, PK(l3, h3), od, 0, 0, 0);
#undef PK
}

struct Args { const bf16* Q; const bf16* K; const bf16* KR; const bf16* V; bf16* O; const bf16* kmean; const float* btab; const float* ropetab; int ldq; };

template <bool MOBA> __device__ __forceinline__ void mask_tile(f32x16& p0, f32x16& p1, int t, int NT, int wid, int r32, int hi, unsigned selmask, const float* btl) {
    const float NEG = -__builtin_inff();
    const int tb = t - (NT - 4);
    const int minrel = 32 * wid - 64 * tb - 63;
    const int qrel = 32 * wid + r32;
    if constexpr (MOBA) {
        if (tb >= -2 && minrel < 113) {
#pragma unroll
            for (int r = 0; r < 16; ++r) { const int rel = qrel - (64 * tb + crow(r, hi)); const int rel1 = rel - 32;
                const float b0 = btl[rel < 0 ? 0 : (rel > 127 ? 127 : rel)], b1 = btl[rel1 < 0 ? 0 : (rel1 > 127 ? 127 : rel1)];
                p0[r] = rel < 0 ? NEG : p0[r] + b0; p1[r] = rel1 < 0 ? NEG : p1[r] + b1; }
        }
        if (tb < 0 && !((selmask >> (t >> 2)) & 1u)) {
#pragma unroll
            for (int r = 0; r < 16; ++r) { p0[r] = NEG; p1[r] = NEG; }
        }
    } else {
        if (tb >= 0 && minrel < 0) {
#pragma unroll
            for (int r = 0; r < 16; ++r) { const int rel = qrel - (64 * tb + crow(r, hi));
                p0[r] = rel < 0 ? NEG : p0[r]; p1[r] = rel - 32 < 0 ? NEG : p1[r]; }
        }
    }
}

template <int DQK, bool MOBA> __device__ __forceinline__ void attn_unit(const Args& a, int b, int h, int qb, char* lds) {
    constexpr int KST = DQK * 2 + 16, ND = DQK / 16;
    int tid_ = threadIdx.x; asm volatile("" : "+v"(tid_));
    const int tid = tid_, lane = tid & 63, r32 = lane & 31, hi = lane >> 5; const int wid = __builtin_amdgcn_readfirstlane(tid >> 6);
    char* Vl = lds + OFF_V; char* Kl = lds + OFF_K;
    float* ws = (float*)(lds + OFF_WS) + wid * 64; float* li_l = ws; float* al_l = ws + 32; const float* btl = (const float*)(lds + OFF_BT);
    const long rowbase = (long)b * SEQ; const int q0 = qb * QB, NT = 4 * (qb + 1);
    bf16x8 qr[ND];
    { const bf16* Qw = a.Q + (rowbase + q0 + wid * QBLK + r32) * a.ldq + hi * 8;
#pragma unroll
      for (int d0 = 0; d0 < ND; ++d0) qr[d0] = *(const bf16x8*)(Qw + (d0 < 4 ? h * 64 + d0 * 16 : 512 + h * 32 + (d0 - 4) * 16)); }
    if constexpr (DQK == 96) {
        typedef float f32x4_ __attribute__((ext_vector_type(4)));
        const float* rt = a.ropetab + ((size_t)(q0 + wid * QBLK + r32) * 16 + 4 * hi) * 2;
#pragma unroll
        for (int d0 = 4; d0 < 6; ++d0) { const f32x4_ c01 = *(const f32x4_*)(rt + (d0 - 4) * 16), c23 = *(const f32x4_*)(rt + (d0 - 4) * 16 + 4);
            u32x4 w = *reinterpret_cast<u32x4*>(&qr[d0]); float x[8];
#pragma unroll
            for (int i = 0; i < 4; ++i) { x[2 * i] = __uint_as_float(w[i] << 16); x[2 * i + 1] = __uint_as_float(w[i] & 0xffff0000u); }
            u32x4 o;
            o[0] = cvtpk(x[0] * c01[0] - x[1] * c01[1], x[1] * c01[0] + x[0] * c01[1]); o[1] = cvtpk(x[2] * c01[2] - x[3] * c01[3], x[3] * c01[2] + x[2] * c01[3]);
            o[2] = cvtpk(x[4] * c23[0] - x[5] * c23[1], x[5] * c23[0] + x[4] * c23[1]); o[3] = cvtpk(x[6] * c23[2] - x[7] * c23[3], x[7] * c23[2] + x[6] * c23[3]);
            qr[d0] = *reinterpret_cast<bf16x8*>(&o); }
    }
    const int sr = tid >> 3, sc8 = tid & 7;
    const bf16* Kg = a.K + (rowbase + sr) * 512 + h * 64 + sc8 * 8;
    const bf16* Vg = a.V + (rowbase + sr) * 512 + h * 64 + sc8 * 8;
    const bf16* KRg = a.KR + (rowbase + (tid >> 2)) * 32 + (tid & 3) * 8;
    const int kst_off = sr * KST + sc8 * 16, krst_off = (tid >> 2) * KST + 128 + (tid & 3) * 16, vst_off = v_st(sr, sc8 * 8);
    const int vb0 = (int)(uintptr_t)Vl + v_rd_base(lane);
    struct { bf16x8 k, v, kr; } sr_[2];
#define SLOAD(i, k0) do { sr_[i].k = *(const bf16x8*)(Kg + (long)(k0) * 512); sr_[i].v = *(const bf16x8*)(Vg + (long)(k0) * 512); \
        if (DQK == 96 && wid < 4) sr_[i].kr = *(const bf16x8*)(KRg + (long)(k0) * 32); } while (0)
#define SWRITE(bf, i) do { *(bf16x8*)(Kl + (bf) * K_BYTES + kst_off) = sr_[i].k; *(bf16x8*)(Vl + (bf) * V_BYTES + vst_off) = sr_[i].v; \
        if (DQK == 96 && wid < 4) *(bf16x8*)(Kl + (bf) * K_BYTES + krst_off) = sr_[i].kr; } while (0)
#define QKT(P0, P1, bf) do { const char* Ks_ = Kl + (bf) * K_BYTES; P0 = f32x16{}; P1 = f32x16{}; \
        _Pragma("unroll") for (int d0 = 0; d0 < ND; ++d0) { \
            const bf16x8 b0_ = *(const bf16x8*)(Ks_ + r32 * KST + (2 * d0 + hi) * 16), b1_ = *(const bf16x8*)(Ks_ + (32 + r32) * KST + (2 * d0 + hi) * 16); \
            P0 = __builtin_amdgcn_mfma_f32_32x32x16_bf16(b0_, qr[d0], P0, 0, 0, 0); P1 = __builtin_amdgcn_mfma_f32_32x32x16_bf16(b1_, qr[d0], P1, 0, 0, 0); } } while (0)
#define PV(bf) do { pv_one<0>(o[0], vb0 + (bf) * V_BYTES, pa0, pa1, pa2, pa3); pv_one<1>(o[1], vb0 + (bf) * V_BYTES, pa0, pa1, pa2, pa3); } while (0)
#define RESC(al) do { if (__any((al) < 1.f)) { if (hi == 0) al_l[r32] = (al); asm volatile("s_waitcnt lgkmcnt(0)" ::: "memory"); \
        _Pragma("unroll") for (int d = 0; d < 2; ++d) _Pragma("unroll") for (int r = 0; r < 16; ++r) o[d][r] *= al_l[crow(r, hi)]; } } while (0)
    unsigned selmask = 0xffffffffu;
    if constexpr (MOBA) {
        if (tid < 256) *(bf16x8*)(lds + OFF_KM + (tid >> 3) * 144 + (tid & 7) * 16) = *(const bf16x8*)(a.kmean + ((long)(b * 8 + h) * 32 + (tid >> 3)) * 64 + (tid & 7) * 8);
        else if (tid < 384) ((float*)(lds + OFF_BT))[tid - 256] = a.btab[h * 128 + tid - 256];
        __syncthreads();
        if (qb > 3) {
            f32x16 g = f32x16{};
#pragma unroll
            for (int d0 = 0; d0 < 4; ++d0) { const bf16x8 ka = *(const bf16x8*)(lds + OFF_KM + r32 * 144 + (2 * d0 + hi) * 16); g = __builtin_amdgcn_mfma_f32_32x32x16_bf16(ka, qr[d0], g, 0, 0, 0); }
            const float NEG = -__builtin_inff();
#pragma unroll
            for (int r = 0; r < 16; ++r) g[r] = crow(r, hi) < qb ? g[r] : NEG;
            float m1 = NEG, m2 = NEG, m3 = NEG;
#pragma unroll
            for (int r = 0; r < 16; ++r) m1 = fmaxf(m1, g[r]);
            { auto rr = __builtin_amdgcn_permlane32_swap(__float_as_uint(m1), __float_as_uint(m1), false, false); m1 = fmaxf(__uint_as_float(rr[0]), __uint_as_float(rr[1])); }
#pragma unroll
            for (int r = 0; r < 16; ++r) m2 = fmaxf(m2, g[r] < m1 ? g[r] : NEG);
            { auto rr = __builtin_amdgcn_permlane32_swap(__float_as_uint(m2), __float_as_uint(m2), false, false); m2 = fmaxf(__uint_as_float(rr[0]), __uint_as_float(rr[1])); }
#pragma unroll
            for (int r = 0; r < 16; ++r) m3 = fmaxf(m3, g[r] < m2 ? g[r] : NEG);
            { auto rr = __builtin_amdgcn_permlane32_swap(__float_as_uint(m3), __float_as_uint(m3), false, false); m3 = fmaxf(__uint_as_float(rr[0]), __uint_as_float(rr[1])); }
            unsigned bits = 0u;
#pragma unroll
            for (int r = 0; r < 16; ++r) bits |= (g[r] >= m3) ? (1u << crow(r, hi)) : 0u;
            { auto rr = __builtin_amdgcn_permlane32_swap(bits, bits, false, false); selmask = rr[0] | rr[1]; }
        }
    }
    float m_reg = -1e30f, l_reg = 0.f; f32x16 o[2]; o[0] = f32x16{}; o[1] = f32x16{};
    f32x16 pA0, pA1, pB0, pB1; float alA, alB; bf16x8 pa0, pa1, pa2, pa3;
    SLOAD(0, 0); SWRITE(0, 0); __syncthreads();
    QKT(pA0, pA1, 0); mask_tile<MOBA>(pA0, pA1, 0, NT, wid, r32, hi, selmask, btl); partialSM(pA0, pA1, m_reg, alA);
    SLOAD(1, KVBLK); if (2 < NT) SLOAD(0, 2 * KVBLK);
    SWRITE(1, 1); __syncthreads();
    for (int j = 1; j + 1 < NT; j += 2) {
        SBAR(); QKT(pB0, pB1, 1);
        finishSM(pA0, pA1, alA, l_reg, pa0, pa1, pa2, pa3); SBAR();
        SLOAD(1, (j + 2) * KVBLK); SBAR();
        PV(0); mask_tile<MOBA>(pB0, pB1, j, NT, wid, r32, hi, selmask, btl); partialSM(pB0, pB1, m_reg, alB);
        __syncthreads(); SWRITE(0, 0);
        RESC(alB); __syncthreads();
        SBAR(); QKT(pA0, pA1, 0);
        finishSM(pB0, pB1, alB, l_reg, pa0, pa1, pa2, pa3); SBAR();
        if (j + 3 < NT) SLOAD(0, (j + 3) * KVBLK); SBAR();
        PV(1); mask_tile<MOBA>(pA0, pA1, j + 1, NT, wid, r32, hi, selmask, btl); partialSM(pA0, pA1, m_reg, alA);
        __syncthreads(); SWRITE(1, 1);
        RESC(alA); __syncthreads();
    }
    SBAR(); QKT(pB0, pB1, 1);
    finishSM(pA0, pA1, alA, l_reg, pa0, pa1, pa2, pa3); SBAR();
    PV(0); mask_tile<MOBA>(pB0, pB1, NT - 1, NT, wid, r32, hi, selmask, btl); partialSM(pB0, pB1, m_reg, alB);
    __syncthreads(); RESC(alB);
    finishSM(pB0, pB1, alB, l_reg, pa0, pa1, pa2, pa3); SBAR();
    PV(1);
    if (hi == 0) li_l[r32] = l_reg; asm volatile("s_waitcnt lgkmcnt(0)" ::: "memory");
    bf16* Ow = a.O + (rowbase + q0 + wid * QBLK) * 512 + h * 64 + r32;
#pragma unroll
    for (int r = 0; r < 16; ++r) { const int orow = crow(r, hi); const float rl = __builtin_amdgcn_rcpf(li_l[orow]);
        const unsigned w0 = cvtpk(o[0][r] * rl, o[1][r] * rl);
        Ow[(long)orow * 512] = (bf16)(w0 & 0xffffu); Ow[(long)orow * 512 + 32] = (bf16)(w0 >> 16); }
    __syncthreads();
#undef SLOAD
#undef SWRITE
#undef QKT
#undef PV
#undef RESC
}

struct SArgs { const bf16* Q; const bf16* K; const bf16* V; bf16* O; const bf16* kmean; const float* btab; unsigned* selm; bf16* PO; float* PM; };
constexpr int SP_KT = 64 * 144;
constexpr int SP_OFF_K = 0, SP_OFF_V = 4 * SP_KT, SP_OFF_LIST = SP_OFF_V + 4 * V_BYTES, SP_OFF_WS = SP_OFF_LIST + 8192 * 4, SP_OFF_BT = SP_OFF_WS + 8 * 1024, SP_OFF_CNT = SP_OFF_BT + 512,
              SP_OFF_KM = SP_OFF_CNT + 64, SP_LDS_BYTES = SP_OFF_KM + 32 * 144;

__device__ __forceinline__ void moba_select_unit(const SArgs& a, int bh, int qb, char* lds) {
    int tid_ = threadIdx.x; asm volatile("" : "+v"(tid_));
    const int tid = tid_, lane = tid & 63, r32 = lane & 31, hi = lane >> 5; const int wid = __builtin_amdgcn_readfirstlane(tid >> 6);
    const int b = bh >> 3, h = bh & 7; const long rowbase = (long)b * SEQ; const int q0 = qb * QB;
    if (tid < 256) *(bf16x8*)(lds + SP_OFF_KM + (tid >> 3) * 144 + (tid & 7) * 16) = *(const bf16x8*)(a.kmean + ((long)bh * 32 + (tid >> 3)) * 64 + (tid & 7) * 8);
    bf16x8 qr[4];
    { const bf16* Qw = a.Q + (rowbase + q0 + wid * QBLK + r32) * 512 + h * 64 + hi * 8;
#pragma unroll
      for (int d0 = 0; d0 < 4; ++d0) qr[d0] = *(const bf16x8*)(Qw + d0 * 16); }
    __syncthreads();
    unsigned selmask = (qb >= 32) ? 0xffffffffu : ((1u << qb) - 1u);
    if (qb > 3) {
        f32x16 g = f32x16{};
#pragma unroll
        for (int d0 = 0; d0 < 4; ++d0) { const bf16x8 ka = *(const bf16x8*)(lds + SP_OFF_KM + r32 * 144 + (2 * d0 + hi) * 16); g = __builtin_amdgcn_mfma_f32_32x32x16_bf16(ka, qr[d0], g, 0, 0, 0); }
        const float NEG = -__builtin_inff();
#pragma unroll
        for (int r = 0; r < 16; ++r) g[r] = crow(r, hi) < qb ? g[r] : NEG;
        float m1 = NEG, m2 = NEG, m3 = NEG;
#pragma unroll
        for (int r = 0; r < 16; ++r) m1 = fmaxf(m1, g[r]);
        { auto rr = __builtin_amdgcn_permlane32_swap(__float_as_uint(m1), __float_as_uint(m1), false, false); m1 = fmaxf(__uint_as_float(rr[0]), __uint_as_float(rr[1])); }
#pragma unroll
        for (int r = 0; r < 16; ++r) m2 = fmaxf(m2, g[r] < m1 ? g[r] : NEG);
        { auto rr = __builtin_amdgcn_permlane32_swap(__float_as_uint(m2), __float_as_uint(m2), false, false); m2 = fmaxf(__uint_as_float(rr[0]), __uint_as_float(rr[1])); }
#pragma unroll
        for (int r = 0; r < 16; ++r) m3 = fmaxf(m3, g[r] < m2 ? g[r] : NEG);
        { auto rr = __builtin_amdgcn_permlane32_swap(__float_as_uint(m3), __float_as_uint(m3), false, false); m3 = fmaxf(__uint_as_float(rr[0]), __uint_as_float(rr[1])); }
        unsigned bits = 0u;
#pragma unroll
        for (int r = 0; r < 16; ++r) bits |= (g[r] >= m3) ? (1u << crow(r, hi)) : 0u;
        { auto rr = __builtin_amdgcn_permlane32_swap(bits, bits, false, false); selmask = rr[0] | rr[1]; }
    }
    if (hi == 0) a.selm[(long)bh * SEQ + q0 + wid * QBLK + r32] = selmask;
    __syncthreads();
}

__device__ __forceinline__ void moba_stage_block(const SArgs& a, int b, int h, int j, char* lds, int tid) {
    const long krow = (long)b * SEQ + (long)j * 256 + (tid >> 3);
#pragma unroll
    for (int i = 0; i < 4; ++i) {
        const bf16x8 kv = *(const bf16x8*)(a.K + (krow + 64 * i) * 512 + h * 64 + (tid & 7) * 8);
        const bf16x8 vv = *(const bf16x8*)(a.V + (krow + 64 * i) * 512 + h * 64 + (tid & 7) * 8);
        *(bf16x8*)(lds + SP_OFF_K + i * SP_KT + (tid >> 3) * 144 + (tid & 7) * 16) = kv;
        *(bf16x8*)(lds + SP_OFF_V + i * V_BYTES + v_st(tid >> 3, (tid & 7) * 8)) = vv;
    }
    if (tid < 128) ((float*)(lds + SP_OFF_BT))[tid] = a.btab[h * 128 + tid];
}
#define SP_QKT(P0, P1, t) do { const char* Ks_ = lds + SP_OFF_K + (t) * SP_KT; P0 = f32x16{}; P1 = f32x16{}; \
        _Pragma("unroll") for (int d0 = 0; d0 < 4; ++d0) { \
            const bf16x8 b0_ = *(const bf16x8*)(Ks_ + r32 * 144 + (2 * d0 + hi) * 16), b1_ = *(const bf16x8*)(Ks_ + (32 + r32) * 144 + (2 * d0 + hi) * 16); \
            P0 = __builtin_amdgcn_mfma_f32_32x32x16_bf16(b0_, qr[d0], P0, 0, 0, 0); P1 = __builtin_amdgcn_mfma_f32_32x32x16_bf16(b1_, qr[d0], P1, 0, 0, 0); } } while (0)
#define SP_RESC(al) do { if (__any((al) < 1.f)) { if (hi == 0) al_l[r32] = (al); asm volatile("s_waitcnt lgkmcnt(0)" ::: "memory"); \
        _Pragma("unroll") for (int d = 0; d < 2; ++d) _Pragma("unroll") for (int r = 0; r < 16; ++r) o[d][r] *= al_l[crow(r, hi)]; } } while (0)

__device__ __forceinline__ void moba_sparse_item(const SArgs& a, int bh, int j, char* lds) {
    int tid_ = threadIdx.x; asm volatile("" : "+v"(tid_));
    const int tid = tid_, lane = tid & 63, r32 = lane & 31, hi = lane >> 5; const int wid = __builtin_amdgcn_readfirstlane(tid >> 6);
    const int b = bh >> 3, h = bh & 7; const long rowbase = (long)b * SEQ;
    unsigned* list = (unsigned*)(lds + SP_OFF_LIST); unsigned* cnt = (unsigned*)(lds + SP_OFF_CNT);
    float* ws = (float*)(lds + SP_OFF_WS) + wid * 256; float* li_l = ws; float* al_l = ws + 32; unsigned* en_l = (unsigned*)(ws + 64); const float* btl = (const float*)(lds + SP_OFF_BT);
    moba_stage_block(a, b, h, j, lds, tid);
    const unsigned* sm = a.selm + (long)bh * SEQ;
    int n = 0;
    for (int base = 256 * (j + 1); base < SEQ; base += 512) {
        const int q = base + tid; const bool inr = q < SEQ; const unsigned m = inr ? sm[q] : 0u;
        const bool sel = ((m >> j) & 1u) != 0u;
        const unsigned long long bal = __ballot(sel);
        if (lane == 0) cnt[wid] = (unsigned)__popcll(bal);
        __syncthreads();
        int woff = n, tot = 0;
#pragma unroll
        for (int w = 0; w < 8; ++w) { const int cw_ = (int)cnt[w]; woff += (w < wid) ? cw_ : 0; tot += cw_; }
        if (sel) list[woff + (int)__popcll(bal & ((1ull << lane) - 1ull))] = (unsigned)q | ((unsigned)__popc(m & ((1u << j) - 1u)) << 16);
        n += tot;
        __syncthreads();
    }
    const int vb0 = (int)(uintptr_t)(lds + SP_OFF_V) + v_rd_base(lane);
    for (int c0 = wid * 32; c0 < n; c0 += 256) {
        const int idx = c0 + r32; const bool valid = idx < n;
        const unsigned e = list[valid ? idx : c0];
        const int q = (int)(e & 0xffffu); const unsigned slot = e >> 16;
        bf16x8 qr[4];
        { const bf16* Qw = a.Q + (rowbase + q) * 512 + h * 64 + hi * 8;
#pragma unroll
          for (int d0 = 0; d0 < 4; ++d0) qr[d0] = *(const bf16x8*)(Qw + d0 * 16); }
        float m_reg = -1e30f, l_reg = 0.f; f32x16 o[2]; o[0] = f32x16{}; o[1] = f32x16{};
#pragma unroll
        for (int t = 0; t < 4; ++t) {
            f32x16 p0, p1; float al; bf16x8 pa0, pa1, pa2, pa3;
            SP_QKT(p0, p1, t);
            const int relb = q - (256 * j + 64 * t) - 4 * hi;
            if (__any(relb - 59 < 113)) {
#pragma unroll
                for (int r = 0; r < 16; ++r) { const int rel = relb - ((r & 3) + 8 * (r >> 2)), rel1 = rel - 32;
                    p0[r] += btl[rel > 127 ? 127 : rel]; p1[r] += btl[rel1 > 127 ? 127 : rel1]; }
            }
            partialSM(p0, p1, m_reg, al);
            SP_RESC(al);
            finishSM(p0, p1, al, l_reg, pa0, pa1, pa2, pa3);
            pv_one<0>(o[0], vb0 + t * V_BYTES, pa0, pa1, pa2, pa3); pv_one<1>(o[1], vb0 + t * V_BYTES, pa0, pa1, pa2, pa3);
        }
        const bool ok = valid && slot < 3u;
        if (hi == 0) { li_l[r32] = l_reg; en_l[r32] = ok ? e : 0xffffffffu; }
        asm volatile("s_waitcnt lgkmcnt(0)" ::: "memory");
        if (hi == 0 && ok) { float* pm = a.PM + (((long)bh * SEQ + q) * 3 + slot) * 2; pm[0] = m_reg; pm[1] = l_reg; }
#pragma unroll
        for (int r = 0; r < 16; ++r) { const int row = crow(r, hi); const unsigned er = en_l[row];
            if (er != 0xffffffffu) { const float rl = __builtin_amdgcn_rcpf(li_l[row]);
                bf16* po = a.PO + (((long)bh * SEQ + (er & 0xffffu)) * 3 + (er >> 16)) * 64 + r32;
                const unsigned w0 = cvtpk(o[0][r] * rl, o[1][r] * rl);
                po[0] = (bf16)(w0 & 0xffffu); po[32] = (bf16)(w0 >> 16); } }
        asm volatile("s_waitcnt lgkmcnt(0)" ::: "memory");
    }
    __syncthreads();
}

__device__ __forceinline__ void moba_own_unit(const SArgs& a, int bh, int qb, char* lds) {
    int tid_ = threadIdx.x; asm volatile("" : "+v"(tid_));
    const int tid = tid_, lane = tid & 63, r32 = lane & 31, hi = lane >> 5; const int wid = __builtin_amdgcn_readfirstlane(tid >> 6);
    const int b = bh >> 3, h = bh & 7; const long rowbase = (long)b * SEQ; const int q0 = qb * QB;
    float* ws = (float*)(lds + SP_OFF_WS) + wid * 256; float* li_l = ws; float* al_l = ws + 32; float* fac = ws + 64; const float* btl = (const float*)(lds + SP_OFF_BT);
    moba_stage_block(a, b, h, qb, lds, tid);
    bf16x8 qr[4];
    { const bf16* Qw = a.Q + (rowbase + q0 + wid * QBLK + r32) * 512 + h * 64 + hi * 8;
#pragma unroll
      for (int d0 = 0; d0 < 4; ++d0) qr[d0] = *(const bf16x8*)(Qw + d0 * 16); }
    __syncthreads();
    const int vb0 = (int)(uintptr_t)(lds + SP_OFF_V) + v_rd_base(lane);
    const int qrel = 32 * wid + r32;
    float m_reg = -1e30f, l_reg = 0.f; f32x16 o[2]; o[0] = f32x16{}; o[1] = f32x16{};
    const float NEG = -__builtin_inff();
#pragma unroll
    for (int t = 0; t < 4; ++t) {
        if (32 * wid + 31 - 64 * t >= 0) {
            f32x16 p0, p1; float al; bf16x8 pa0, pa1, pa2, pa3;
            SP_QKT(p0, p1, t);
            if (32 * wid - 64 * t - 63 < 113) {
#pragma unroll
                for (int r = 0; r < 16; ++r) { const int rel = qrel - (64 * t + crow(r, hi)), rel1 = rel - 32;
                    const float b0 = btl[rel < 0 ? 0 : (rel > 127 ? 127 : rel)], b1 = btl[rel1 < 0 ? 0 : (rel1 > 127 ? 127 : rel1)];
                    p0[r] = rel < 0 ? NEG : p0[r] + b0; p1[r] = rel1 < 0 ? NEG : p1[r] + b1; }
            }
            partialSM(p0, p1, m_reg, al);
            SP_RESC(al);
            finishSM(p0, p1, al, l_reg, pa0, pa1, pa2, pa3);
            pv_one<0>(o[0], vb0 + t * V_BYTES, pa0, pa1, pa2, pa3); pv_one<1>(o[1], vb0 + t * V_BYTES, pa0, pa1, pa2, pa3);
        }
    }
    const long qg = (long)bh * SEQ + q0 + wid * QBLK + r32;
    const unsigned mask = qb > 0 ? a.selm[qg] : 0u; int nsel = __popc(mask); nsel = nsel > 3 ? 3 : nsel;
    float ms[3], ls[3];
#pragma unroll
    for (int s = 0; s < 3; ++s) { ms[s] = -1e30f; ls[s] = 0.f; if (s < nsel) { const float* pm = a.PM + (qg * 3 + s) * 2; ms[s] = pm[0]; ls[s] = pm[1]; } }
    const float M = fmaxf(fmaxf(m_reg, ms[0]), fmaxf(ms[1], ms[2]));
    const float w0 = l_reg * __builtin_amdgcn_exp2f(m_reg - M);
    float wsum = w0, wv[3];
#pragma unroll
    for (int s = 0; s < 3; ++s) { wv[s] = ls[s] * __builtin_amdgcn_exp2f(ms[s] - M); wsum += wv[s]; }
    const float rL = __builtin_amdgcn_rcpf(wsum);
    if (hi == 0) { li_l[r32] = l_reg; fac[r32] = __builtin_amdgcn_exp2f(m_reg - M) * rL; fac[32 + r32] = wv[0] * rL; fac[64 + r32] = wv[1] * rL; fac[96 + r32] = wv[2] * rL; }
    asm volatile("s_waitcnt lgkmcnt(0)" ::: "memory");
    bf16* Ow = a.O + (rowbase + q0 + wid * QBLK) * 512 + h * 64 + r32;
    const bf16* pob = a.PO + (((long)bh * SEQ + q0 + wid * QBLK) * 3) * 64 + r32;
#pragma unroll
    for (int r = 0; r < 16; ++r) { const int row = crow(r, hi);
        const float f0 = fac[row], f1 = fac[32 + row], f2 = fac[64 + row], f3 = fac[96 + row];
        float x0 = o[0][r] * f0, x1 = o[1][r] * f0;
        const bf16* pr = pob + (long)row * 192;
        if (f1 != 0.f) { x0 += __uint_as_float((unsigned)pr[0] << 16) * f1; x1 += __uint_as_float((unsigned)pr[32] << 16) * f1; }
        if (f2 != 0.f) { x0 += __uint_as_float((unsigned)pr[64] << 16) * f2; x1 += __uint_as_float((unsigned)pr[96] << 16) * f2; }
        if (f3 != 0.f) { x0 += __uint_as_float((unsigned)pr[128] << 16) * f3; x1 += __uint_as_float((unsigned)pr[160] << 16) * f3; }
        const unsigned w = cvtpk(x0, x1);
        Ow[(long)row * 512] = (bf16)(w & 0xffffu); Ow[(long)row * 512 + 32] = (bf16)(w >> 16); }
    __syncthreads();
}
#undef SP_QKT
#undef SP_RESC
#undef SBAR
}

constexpr int NWAVES = 8;
constexpr size_t MiB = 1u << 20;
constexpr size_t WS_CTL = 0, CTL_ZERO_BYTES = 1 * MiB;
constexpr size_t WS_ROPE = 1 * MiB;
constexpr size_t WS_SSQ = 2 * MiB;
constexpr size_t WS_KMEAN = 2 * MiB + 512 * 1024;
constexpr size_t WS_BTAB = 2 * MiB + 768 * 1024;
constexpr size_t WS_BT1 = 4 * MiB, WS_BT2 = 12 * MiB, WS_BT2B = 12 * MiB + 512 * 1024, WS_BT3A = 13 * MiB, WS_BT3B = 14 * MiB, WS_BT4 = 15 * MiB, WS_BT5 = 17 * MiB, WS_BT6 = 28 * MiB;
constexpr size_t WS_BASE = 38 * MiB;
constexpr size_t WS_XN = WS_BASE, WS_QM = WS_BASE, WS_MIX = WS_BASE;
constexpr size_t WS_QA = 102 * MiB, WS_KA = 134 * MiB, WS_VA = 166 * MiB;
constexpr size_t WS_SCR = WS_QA;
constexpr size_t WS_CQ = 198 * MiB, WS_CKV = 214 * MiB, WS_KR = 222 * MiB;
constexpr size_t WS_GATE = 224 * MiB;
constexpr size_t WS_KN = 352 * MiB, WS_VM = 384 * MiB, WS_YA = 416 * MiB, WS_YB = 448 * MiB;
constexpr size_t WS_U = WS_BASE;
constexpr size_t WS_H1B = 390 * MiB;
constexpr size_t WS_UH = 454 * MiB;
constexpr size_t WS_END = 480 * MiB;
constexpr int CW_TMO = 0, CW_CODE = 1, CW_Q = 64, CW_BAR = 4096;

constexpr int RING_OFF = 0, RING_BYTES = 131072;
constexpr int LDSCTL_OFF = RING_BYTES, MISC_OFF = LDSCTL_OFF + 320;
constexpr int LDS_BYTES = 147456;
static_assert(att::SP_LDS_BYTES <= RING_BYTES && att::LDS_BYTES <= RING_BYTES, "attention scratch fits the ring region");

#define GAS __attribute__((address_space(1)))
#define LAS __attribute__((address_space(3)))
typedef unsigned short bf16;
typedef unsigned v4u __attribute__((ext_vector_type(4)));
typedef float f32x4 __attribute__((ext_vector_type(4)));
typedef float f32x2 __attribute__((ext_vector_type(2)));
typedef GAS unsigned gu32;
#define RLX_AGENT __ATOMIC_RELAXED, __HIP_MEMORY_SCOPE_AGENT
#define LDS_WAIT() asm volatile("s_waitcnt lgkmcnt(0)" ::: "memory")
#define VM_WAIT() asm volatile("s_waitcnt vmcnt(0)" ::: "memory")
__device__ __forceinline__ unsigned f2bf(float f) { unsigned u = __builtin_bit_cast(unsigned, f); return (u + 0x7fffu + ((u >> 16) & 1u)) >> 16; }
__device__ __forceinline__ unsigned pk2(float lo, float hi) { return f2bf(lo) | (f2bf(hi) << 16); }

#define XB_TMO      128
#define XB_XCNT(j)  (256  + 64 * (j))
#define XB_XSUB(j)  (1280 + 64 * (j))
#define XB_XGEN(j)  (2304 + 64 * (j))
#define XB_TOP      3328
#define XB_TOPGEN   3392
#define XCD_BAR_WORDS 3456
#define XB_SPIN_CAP (1u << 18)
__device__ __forceinline__ unsigned xb_ld(unsigned* p)              { return __hip_atomic_load(p, __ATOMIC_RELAXED, __HIP_MEMORY_SCOPE_AGENT); }
__device__ __forceinline__ unsigned xb_add(unsigned* p, unsigned v) { return __hip_atomic_fetch_add(p, v, __ATOMIC_RELAXED, __HIP_MEMORY_SCOPE_AGENT); }
__device__ __forceinline__ unsigned xb_xcc_id() { return (unsigned)__builtin_amdgcn_s_getreg((3 << 11) | 20) & 0xFu; }
#define XB_SPIN(cond, bar) do { unsigned _sp = 0; while (cond) { __builtin_amdgcn_s_sleep(1); \
    if ((++_sp & 255u) == 0u) { if (xb_ld(&(bar)[XB_TMO])) break; if (_sp > XB_SPIN_CAP) { atomicAdd(&(bar)[XB_TMO], 1u); break; } } } } while (0)
struct XcdBarrier { unsigned* bar; unsigned x; volatile LAS unsigned* st; };
__device__ __forceinline__ XcdBarrier xcd_barrier_post(unsigned* bar, volatile LAS unsigned* st) {
    XcdBarrier b; b.bar = bar; b.x = xb_xcc_id(); b.st = st;
    if (threadIdx.x == 0) (void)xb_add(&bar[XB_XCNT(b.x)], 1u);
    return b;
}
__device__ __forceinline__ void xcd_barrier_complete(unsigned* bar, unsigned x, unsigned& nloc, unsigned& nx) {
    const unsigned G = gridDim.x * gridDim.y * gridDim.z;
    unsigned sum, cnt, mine, sp = 0u;
    for (;;) {
        sum = 0u; cnt = 0u; mine = 0u;
#pragma unroll
        for (unsigned j = 0; j < 16; ++j) { const unsigned c = xb_ld(&bar[XB_XCNT(j)]); sum += c; cnt += (c > 0u) ? 1u : 0u; mine = (j == x) ? c : mine; }
        if (sum == G) break;
        __builtin_amdgcn_s_sleep(1);
        if ((++sp & 255u) == 0u) { if (xb_ld(&bar[XB_TMO])) break; if (sp > XB_SPIN_CAP) { atomicAdd(&bar[XB_TMO], 1u); break; } }
    }
    nloc = mine > 0u ? mine : 1u; nx = cnt > 0u ? cnt : 1u;
}
__device__ __forceinline__ void xcd_barrier(const XcdBarrier& b) {
    asm volatile("s_waitcnt vmcnt(0)" ::: "memory");
    __syncthreads();
    if (threadIdx.x == 0) {
        unsigned* bar = b.bar;
        __builtin_amdgcn_s_waitcnt(0);
        unsigned nloc = b.st[0], nx = b.st[1];
        if (nloc == 0u) { xcd_barrier_complete(bar, b.x, nloc, nx); b.st[0] = nloc; b.st[1] = nx; }
        const unsigned old = xb_add(&bar[XB_XSUB(b.x)], 1u);
        const unsigned gen = old / nloc;
        if (old + 1u == (gen + 1u) * nloc) {
            __builtin_amdgcn_fence(__ATOMIC_RELEASE, "agent");
            asm volatile("s_waitcnt vmcnt(0)" ::: "memory");
            const unsigned og = xb_add(&bar[XB_TOP], 1u);
            const unsigned tg = og / nx;
            if (og + 1u == (tg + 1u) * nx) xb_add(&bar[XB_TOPGEN], 1u);
            else XB_SPIN(xb_ld(&bar[XB_TOPGEN]) == tg, bar);
            __builtin_amdgcn_fence(__ATOMIC_ACQUIRE, "agent");
            xb_add(&bar[XB_XGEN(b.x)], 1u);
            asm volatile("s_waitcnt vmcnt(0)" ::: "memory");
        } else {
            XB_SPIN(xb_ld(&bar[XB_XGEN(b.x)]) == gen, bar);
            __builtin_amdgcn_fence(__ATOMIC_ACQUIRE, "agent");
            asm volatile("s_waitcnt vmcnt(0)" ::: "memory");
        }
    }
    __syncthreads();
}

__device__ __forceinline__ float wave_sum(float v) {
#pragma unroll
    for (int o = 1; o < 64; o <<= 1) v += __shfl_xor(v, o);
    return v;
}
struct MapId { __device__ __forceinline__ int operator()(int n) const { return n; } };
struct MapIn { __device__ __forceinline__ int operator()(int n) const {
    if (n < 1920) return n;
    if (n < 1952) { const int j = n - 1920; return 1920 + (j & 1) * 16 + (j >> 1); }
    if (n < 2048) return -1;
    return 1952 + (n - 2048); } };
struct MapUq { __device__ __forceinline__ int operator()(int n) const { if (n < 512) return (n >> 6) * 96 + (n & 63); const int h = (n - 512) >> 5, j = n & 31; return h * 96 + 64 + (j & 1) * 16 + (j >> 1); } };
struct MapUkv { __device__ __forceinline__ int operator()(int n) const { const int hh = (n & 511) >> 6, d = n & 63; return hh * 128 + (n >> 9) * 64 + d; } };
template <class CM> __device__ __forceinline__ void p0_transpose_item(const float* W, int K, int N, int NP, bf16* WT, const float* kscale, LAS float* scr, int item, int lane, CM cm) {
    const int nblk = NP / 32, kb = item / nblk, nb = item % nblk, k0 = 64 * kb, n0 = 32 * nb;
    const int sc = cm(n0 + (lane & 31));
#pragma unroll 8
    for (int i = 0; i < 32; ++i) { const int kk = 2 * i + (lane >> 5); float v = 0.f; if (sc >= 0) { v = W[(size_t)(k0 + kk) * N + sc]; if (kscale) v *= kscale[k0 + kk]; } scr[kk * 33 + (lane & 31)] = v; }
    LDS_WAIT(); asm volatile("" ::: "memory");
    const int c = lane & 7;
#pragma unroll
    for (int j = 0; j < 4; ++j) { const int n = (lane >> 3) + 8 * j; const LAS float* s = scr + (8 * c) * 33 + n;
        v4u o; o.x = pk2(s[0 * 33], s[1 * 33]); o.y = pk2(s[2 * 33], s[3 * 33]); o.z = pk2(s[4 * 33], s[5 * 33]); o.w = pk2(s[6 * 33], s[7 * 33]);
        *(GAS v4u*)(WT + (size_t)(n0 + n) * K + k0 + 8 * c) = o; }
    LDS_WAIT(); asm volatile("" ::: "memory");
}
__device__ const float INV_FREQ[16] = {1.000000000e+00f, 5.623413324e-01f, 3.162277639e-01f, 1.778279394e-01f, 1.000000015e-01f, 5.623413250e-02f, 3.162277490e-02f, 1.778279431e-02f,
                                       9.999999776e-03f, 5.623413250e-03f, 3.162277630e-03f, 1.778279431e-03f, 1.000000047e-03f, 5.623413017e-04f, 3.162277571e-04f, 1.778279402e-04f};
__device__ __forceinline__ void sincos_rev(float ang, float& s, float& c) {
    const float c_hi = 0.15915494309189535f;
    const float c_lo = (float)(0.15915494309189535 - (double)0.15915494309189535f);
    const float t_hi = ang * c_hi; const float t_lo = __builtin_fmaf(ang, c_hi, -t_hi) + ang * c_lo;
    float fr = (t_hi - __builtin_floorf(t_hi)) + t_lo;
    s = __builtin_amdgcn_sinf(fr); c = __builtin_amdgcn_cosf(fr);
}

#ifndef REP_MOBA
#define REP_MOBA 1
#endif
#ifndef REP_MLA
#define REP_MLA 1
#endif
#ifndef PHMASK
#define PHMASK 0x3ff
#endif
struct KArgs { const float* in[18]; float* out; unsigned char* ws; };


#ifdef DBG_STOP
#define DBG_DUMP(n) do { if (DBG_STOP == (n)) { PHASE_PTRS(); \
    for (int i = gt; i < T * 1024; i += NGT) { const int r = i >> 10, c = i & 1023; float v = 0.f; \
        if ((n) == 0) v = pg8::bf2f(XN[(size_t)r * 1024 + c]) + pg8::bf2f(Bt1[(size_t)(r & 4095) * 1024 + c]) + pg8::bf2f(Bt5[(size_t)(r % 5632) * 1024 + c]) + pg8::bf2f(Bt6[(size_t)(r & 1023) * 2816 + c]) + pg8::bf2f(Bt4[(size_t)(r & 1023) * 1024 + c]) + ropetab[(r & 8191) * 16 + (c & 15)].x; \
        if ((n) == 1) v = pg8::bf2f(QA[(size_t)r * 512 + (c & 511)]) + pg8::bf2f(KA[(size_t)r * 512 + (c & 511)]) + pg8::bf2f(VA[(size_t)r * 512 + (c & 511)]) + pg8::bf2f(CQ[(size_t)r * 256 + (c & 255)]) \
              + pg8::bf2f(CKV[(size_t)r * 128 + (c & 127)]) + pg8::bf2f(KR[(size_t)r * 32 + (c & 31)]) + pg8::bf2f(GATE[(size_t)r * 2048 + c]) + pg8::bf2f(GATE[(size_t)r * 2048 + 1024 + c]); \
        if ((n) == 2) v = pg8::bf2f(QM[(size_t)r * 768 + (c % 768)]) + pg8::bf2f(KN[(size_t)r * 512 + (c & 511)]) + pg8::bf2f(VM[(size_t)r * 512 + (c & 511)]) + pg8::bf2f(KMEAN[(size_t)(r & 1023) * 64 + (c & 63)]); \
        if ((n) == 3) v = (c < 512) ? pg8::bf2f(YA[(size_t)r * 512 + c]) : pg8::bf2f(YB[(size_t)r * 512 + (c & 511)]); \
        if ((n) == 4) v = pg8::bf2f(MIX[(size_t)r * 1024 + c]); \
        if ((n) == 5) v = pg8::bf2f(H1B[(size_t)r * 1024 + c]); \
        if ((n) == 6) v = pg8::bf2f(U[(size_t)r * 5632 + c]) + pg8::bf2f(U[(size_t)r * 5632 + 1024 + c]) + pg8::bf2f(U[(size_t)r * 5632 + 2048 + c]) + pg8::bf2f(U[(size_t)r * 5632 + 3072 + c]) + pg8::bf2f(U[(size_t)r * 5632 + 4096 + c]) + pg8::bf2f(U[(size_t)r * 5632 + 4608 + c]); \
        if ((n) == 7) v = pg8::bf2f(U[(size_t)r * 5632 + c]) + pg8::bf2f(U[(size_t)r * 5632 + 1024 + c]) + pg8::bf2f(U[(size_t)r * 5632 + 1792 + c]); \
        out[i] = v; } return; } } while (0)
#else
#define DBG_DUMP(n) do {} while (0)
#endif
#define PHASE_PTRS() \
    int tid = threadIdx.x; asm volatile("" : "+v"(tid)); const int lane = tid & 63, wave = __builtin_amdgcn_readfirstlane(tid >> 6); \
    const int gw = vcu * NWAVES + wave, NGW = G * NWAVES, gt = (vcu * NWAVES * 64) + tid, NGT = G * NWAVES * 64; (void)lane; (void)wave; (void)gw; (void)NGW; (void)gt; (void)NGT; \
    const KArgs __attribute__((address_space(4)))* ap_ = (const KArgs __attribute__((address_space(4)))*)__builtin_amdgcn_kernarg_segment_ptr(); asm volatile("" : "+s"(ap_)); unsigned char* ws = ap_->ws; (void)ws; \
    const float* x = ap_->in[0]; const float* norm_attn_g = ap_->in[1]; const float* w_in = ap_->in[2]; const float* b_gate = ap_->in[3]; \
    const float* q_norm_g = ap_->in[4]; const float* w_uq = ap_->in[5]; const float* kv_norm_g = ap_->in[6]; const float* w_ukv = ap_->in[7]; \
    const float* rel_bias = ap_->in[8]; const float* w_bm = ap_->in[9]; const float* w_bl = ap_->in[10]; const float* w_out = ap_->in[11]; \
    const float* norm_ffn_g = ap_->in[12]; const float* w_up = ap_->in[13]; const float* conv_w = ap_->in[14]; const float* conv_b = ap_->in[15]; \
    const float* w_down = ap_->in[16]; const float* norm_final_g = ap_->in[17]; float* out = ap_->out; \
    (void)x; (void)norm_attn_g; (void)w_in; (void)b_gate; (void)q_norm_g; (void)w_uq; (void)kv_norm_g; (void)w_ukv; (void)rel_bias; (void)w_bm; (void)w_bl; (void)w_out; \
    (void)norm_ffn_g; (void)w_up; (void)conv_w; (void)conv_b; (void)w_down; (void)norm_final_g; (void)out; \
    f32x2* ropetab = (f32x2*)(ws + WS_ROPE); (void)ropetab; \
    float* ssq_cq = (float*)(ws + WS_SSQ); float* ssq_ckv = ssq_cq + T; float* ssq_h1 = ssq_ckv + T; float* ssq_h2 = ssq_h1 + T; (void)ssq_cq; (void)ssq_ckv; (void)ssq_h1; (void)ssq_h2; \
    bf16* KMEAN = (bf16*)(ws + WS_KMEAN); float* BTAB = (float*)(ws + WS_BTAB); (void)KMEAN; (void)BTAB; \
    bf16 *Bt1 = (bf16*)(ws + WS_BT1), *Bt2 = (bf16*)(ws + WS_BT2), *Bt2b = (bf16*)(ws + WS_BT2B), *Bt3a = (bf16*)(ws + WS_BT3A), *Bt3b = (bf16*)(ws + WS_BT3B), \
         *Bt4 = (bf16*)(ws + WS_BT4), *Bt5 = (bf16*)(ws + WS_BT5), *Bt6 = (bf16*)(ws + WS_BT6); (void)Bt1; (void)Bt2; (void)Bt2b; (void)Bt3a; (void)Bt3b; (void)Bt4; (void)Bt5; (void)Bt6; \
    bf16 *XN = (bf16*)(ws + WS_XN), *QM = (bf16*)(ws + WS_QM), *MIX = (bf16*)(ws + WS_MIX), *QA = (bf16*)(ws + WS_QA), *KA = (bf16*)(ws + WS_KA), *VA = (bf16*)(ws + WS_VA), \
         *CQ = (bf16*)(ws + WS_CQ), *CKV = (bf16*)(ws + WS_CKV), *KR = (bf16*)(ws + WS_KR), *GATE = (bf16*)(ws + WS_GATE), *KN = (bf16*)(ws + WS_KN), *VM = (bf16*)(ws + WS_VM), \
         *YA = (bf16*)(ws + WS_YA), *YB = (bf16*)(ws + WS_YB), *U = (bf16*)(ws + WS_U), *H1B = (bf16*)(ws + WS_H1B), *UH = (bf16*)(ws + WS_UH); \
    (void)XN; (void)QM; (void)MIX; (void)QA; (void)KA; (void)VA; (void)CQ; (void)CKV; (void)KR; (void)GATE; (void)KN; (void)VM; (void)YA; (void)YB; (void)U; (void)H1B; (void)UH

__global__ void __launch_bounds__(NWAVES * 64, 2) hybrid_fwd(KArgs args) {
    extern __shared__ __attribute__((aligned(16))) unsigned char lds[];
    LAS unsigned char* ldsl = (LAS unsigned char*)lds;
    volatile LAS unsigned* MISC = (volatile LAS unsigned*)(ldsl + MISC_OFF);
    const int G = gridDim.x; const int bx = blockIdx.x; const int vcu = (G % 8 == 0) ? (bx % 8) * (G / 8) + bx / 8 : bx;
    gu32* ctl = (gu32*)(args.ws + WS_CTL);
    for (int u = threadIdx.x; u < (LDS_BYTES - LDSCTL_OFF) / 4; u += NWAVES * 64) ((LAS unsigned*)(ldsl + LDSCTL_OFF))[u] = 0u;
    __syncthreads();
    XcdBarrier bar = xcd_barrier_post((unsigned*)(ctl + CW_BAR), MISC + 8);
#define GRID_BAR() xcd_barrier(bar)

    if (PHMASK & (1 << 0)) {
        PHASE_PTRS();
        LAS float* scr = (LAS float*)(ldsl + RING_OFF + wave * 16384);
        constexpr int I1 = (DM / 64) * (NP1 / 32), I2 = (256 / 64) * (768 / 32), I2B = (128 / 64) * (1024 / 32), I3 = (512 / 64) * (DM / 32), I4 = (DM / 64) * (DM / 32),
                      I5 = (DM / 64) * (DFF2 / 32), I6 = (DFF / 64) * (DM / 32);
        constexpr int NITEMS = I1 + I2 + I2B + 2 * I3 + I4 + I5 + I6;
        for (int it = gw; it < NITEMS; it += NGW) {
            int r = it;
            if (r < I1) { p0_transpose_item(w_in, DM, IN_COLS, NP1, Bt1, nullptr, scr, r, lane, MapIn()); continue; } r -= I1;
            if (r < I2) { p0_transpose_item(w_uq, 256, 768, 768, Bt2, q_norm_g, scr, r, lane, MapUq()); continue; } r -= I2;
            if (r < I2B) { p0_transpose_item(w_ukv, 128, 1024, 1024, Bt2b, kv_norm_g, scr, r, lane, MapUkv()); continue; } r -= I2B;
            if (r < I3) { p0_transpose_item(w_bm, 512, DM, DM, Bt3a, nullptr, scr, r, lane, MapId()); continue; } r -= I3;
            if (r < I3) { p0_transpose_item(w_bl, 512, DM, DM, Bt3b, nullptr, scr, r, lane, MapId()); continue; } r -= I3;
            if (r < I4) { p0_transpose_item(w_out, DM, DM, DM, Bt4, nullptr, scr, r, lane, MapId()); continue; } r -= I4;
            if (r < I5) { p0_transpose_item(w_up, DM, DFF2, DFF2, Bt5, norm_ffn_g, scr, r, lane, MapId()); continue; } r -= I5;
            p0_transpose_item(w_down, DFF, DM, DM, Bt6, nullptr, scr, r, lane, MapId());
        }
        for (int m = gw; m < T; m += NGW) {
            const GAS f32x4* xr = (const GAS f32x4*)(x + (size_t)m * DM) + lane; const GAS f32x4* gr = (const GAS f32x4*)norm_attn_g + lane;
            f32x4 v[4]; float s = 0.f;
#pragma unroll
            for (int j = 0; j < 4; ++j) { v[j] = xr[64 * j]; s += (v[j].x * v[j].x + v[j].y * v[j].y) + (v[j].z * v[j].z + v[j].w * v[j].w); }
            const float rinv = 1.0f / sqrtf(wave_sum(s) * (1.f / DM) + EPS);
            GAS unsigned long long* o8 = (GAS unsigned long long*)(XN + (size_t)m * DM) + lane;
#pragma unroll
            for (int j = 0; j < 4; ++j) { const f32x4 gg = gr[64 * j];
                o8[64 * j] = (unsigned long long)pk2(v[j].x * rinv * gg.x, v[j].y * rinv * gg.y) | ((unsigned long long)pk2(v[j].z * rinv * gg.z, v[j].w * rinv * gg.w) << 32); }
        }
        for (int i = gt; i < 4 * T; i += NGT) ssq_cq[i] = 0.f;
        for (int i = gt; i < SEQ * 16; i += NGT) { const int pos = i >> 4, j = i & 15; float s, c; sincos_rev((float)pos * INV_FREQ[j], s, c); ropetab[i] = (f32x2){c, s}; }
        for (int i = gt; i < 8 * 128; i += NGT) { const int h = i >> 7, rel = i & 127;
            int bk = rel; if (rel >= 16) { bk = 16 + (int)(logf((float)rel / 16.0f) / logf(8.0f) * 16.0f); bk = bk > 31 ? 31 : bk; }
            BTAB[i] = (rel_bias[bk * 8 + h] - rel_bias[31 * 8 + h]) * LOG2E; }
    }
    GRID_BAR();
    DBG_DUMP(0);

    if (PHMASK & (1 << 1)) {
        PHASE_PTRS();
        pg8::Gemm g{XN, 0, Bt1, 0, DM, DM}; pg8::StaticOrder S; S.init(T, NP1, G, bx);
        pg8::EpiProj E{QA, (long)((WS_KA - WS_QA) / 2), CQ, CKV, KR, GATE, ssq_cq, ssq_ckv, b_gate, (const pg8::f32x2*)ropetab};
        pg8::gemm_phase<pg8::EpiProj, pg8::StaticOrder, true, true>(ldsl + RING_OFF, g, S, E);
    }
    GRID_BAR();
    DBG_DUMP(1);

    if (PHMASK & (1 << 2)) {
        PHASE_PTRS();
        {   pg8::Gemm g{CQ, 0, Bt2, 0, 256, 256}; pg8::StaticOrder S; S.init(T, 768, G, bx);
            pg8::EpiQup E{QM, ssq_cq, (const pg8::f32x2*)ropetab};
            pg8::gemm_phase<pg8::EpiQup, pg8::StaticOrder, true, true>(ldsl + RING_OFF, g, S, E); }
        {   pg8::Gemm g{CKV, 0, Bt2b, 0, 128, 128}; pg8::StaticOrder S; S.init(T, 1024, G, bx);
            pg8::EpiKVup E{KN, (long)((WS_VM - WS_KN) / 2), ssq_ckv};
            pg8::gemm_phase<pg8::EpiKVup, pg8::StaticOrder, true, true>(ldsl + RING_OFF, g, S, E); }
        __syncthreads();
        LAS float* red = (LAS float*)(ldsl + RING_OFF);
        for (int it = vcu; it < BATCH * 32; it += G) {
            const int c = tid & 63, rg = tid >> 6; const bf16* src = KA + ((size_t)it * 256 + rg * 32) * 512 + c * 8;
            float s[8];
#pragma unroll
            for (int i = 0; i < 8; ++i) s[i] = 0.f;
#pragma unroll 4
            for (int r = 0; r < 32; ++r) { const v4u w = *(const v4u*)(src + (size_t)r * 512); f32x4 a, b2; pg8::unpack8(w, a, b2);
                s[0] += a[0]; s[1] += a[1]; s[2] += a[2]; s[3] += a[3]; s[4] += b2[0]; s[5] += b2[1]; s[6] += b2[2]; s[7] += b2[3]; }
#pragma unroll
            for (int i = 0; i < 8; ++i) red[rg * 512 + c * 8 + i] = s[i];
            __syncthreads();
            { float t = 0.f;
#pragma unroll
              for (int r = 0; r < 8; ++r) t += red[r * 512 + tid];
              const int b = it >> 5, blk = it & 31, h = tid >> 6, d = tid & 63;
              KMEAN[((size_t)(b * 8 + h) * 32 + blk) * 64 + d] = (bf16)f2bf(t * (1.0f / 256.0f)); }
            __syncthreads();
        }
    }
    GRID_BAR();
    DBG_DUMP(2);

    if (PHMASK & (1 << 3)) {
        PHASE_PTRS();
        att::SArgs sa{QA, KA, VA, YA, KMEAN, BTAB, (unsigned*)((char*)out + 104 * MiB), (bf16*)out, (float*)((char*)out + 96 * MiB)};
        for (int it = vcu; it < 1024; it += G) { const int bh = it >> 5, qb = it & 31; if (qb > 0) att::moba_select_unit(sa, bh, qb, (char*)lds + RING_OFF); }
        att::Args al{QM, KN, KR, VM, YB, nullptr, nullptr, (const float*)ropetab, 768};
        for (int rep_ = 0; rep_ < REP_MLA; ++rep_)
        for (int it = vcu; it < 512; it += G) { const int bh = it >> 4, s = it & 15;
            att::attn_unit<96, false>(al, bh >> 3, bh & 7, 31 - s, (char*)lds + RING_OFF);
            att::attn_unit<96, false>(al, bh >> 3, bh & 7, s, (char*)lds + RING_OFF); }
    }
    GRID_BAR();
    if (PHMASK & (1 << 3)) {
        PHASE_PTRS();
        att::SArgs sa{QA, KA, VA, YA, KMEAN, BTAB, (unsigned*)((char*)out + 104 * MiB), (bf16*)out, (float*)((char*)out + 96 * MiB)};
        volatile LAS unsigned* qslot = (volatile LAS unsigned*)(ldsl + MISC_OFF + 64);
        for (;;) {
            if (tid == 0) qslot[0] = __hip_atomic_fetch_add((unsigned*)(ctl + CW_Q), 1u, __ATOMIC_RELAXED, __HIP_MEMORY_SCOPE_AGENT);
            __syncthreads();
            const int id = (int)qslot[0];
            __syncthreads();
            if (id >= 31 * 32) break;
            att::moba_sparse_item(sa, id & 31, id >> 5, (char*)lds + RING_OFF);
        }
    }
    GRID_BAR();
    if (PHMASK & (1 << 3)) {
        PHASE_PTRS();
        att::SArgs sa{QA, KA, VA, YA, KMEAN, BTAB, (unsigned*)((char*)out + 104 * MiB), (bf16*)out, (float*)((char*)out + 96 * MiB)};
        for (int it = vcu; it < 1024; it += G) att::moba_own_unit(sa, it >> 5, it & 31, (char*)lds + RING_OFF);
    }
    GRID_BAR();
    DBG_DUMP(3);

    if (PHMASK & (1 << 4)) {
        PHASE_PTRS();
        pg8::Gemm g{YA, (long)((WS_YB - WS_YA) / 2), Bt3a, (long)((WS_BT3B - WS_BT3A) / 2), 512, 512}; pg8::StaticOrder S; S.init(T, DM, G, bx, 2);
        pg8::EpiMix E{GATE, MIX};
        pg8::gemm_phase<pg8::EpiMix, pg8::StaticOrder, true, true>(ldsl + RING_OFF, g, S, E);
    }
    GRID_BAR();
    DBG_DUMP(4);

    if (PHMASK & (1 << 5)) {
        PHASE_PTRS();
        pg8::Gemm g{MIX, 0, Bt4, 0, DM, DM}; pg8::StaticOrder S; S.init(T, DM, G, bx);
        pg8::EpiOut E{x, out, H1B, ssq_h1};
        pg8::gemm_phase<pg8::EpiOut, pg8::StaticOrder, true, true>(ldsl + RING_OFF, g, S, E);
    }
    GRID_BAR();
    DBG_DUMP(5);

    if (PHMASK & (1 << 6)) {
        PHASE_PTRS();
        pg8::Gemm g{H1B, 0, Bt5, 0, DM, DM}; pg8::StaticOrder S; S.init(T, DFF2, G, bx);
        pg8::EpiUp E{U, UH, ssq_h1};
        pg8::gemm_phase<pg8::EpiUp, pg8::StaticOrder, true, true>(ldsl + RING_OFF, g, S, E);
    }
    GRID_BAR();
    DBG_DUMP(6);

    if (PHMASK & (1 << 7)) {
        PHASE_PTRS();
        constexpr int NCH = DFF / 8;
        for (int it = gt; it < (T / 32) * NCH; it += NGT) {
            const int seg = it / NCH, ch = it % NCH, c = ch * 8; const int row0 = seg * 32;
            float wg[3][8], wv[3][8], bg[8], bvv[8];
#pragma unroll
            for (int j = 0; j < 3; ++j)
#pragma unroll
                for (int i = 0; i < 8; ++i) { wg[j][i] = conv_w[j * DFF2 + c + i]; wv[j][i] = conv_w[j * DFF2 + DFF + c + i]; }
#pragma unroll
            for (int i = 0; i < 8; ++i) { bg[i] = conv_b[c + i]; bvv[i] = conv_b[DFF + c + i]; }
            f32x4 g2a, g2b, g1a, g1b, v2a, v2b, v1a, v1b;
            if ((row0 & (SEQ - 1)) == 0) { g2a = g2b = g1a = g1b = v2a = v2b = v1a = v1b = (f32x4){0.f, 0.f, 0.f, 0.f}; }
            else { const bf16* hp = UH + (size_t)(seg - 1) * 2 * DFF2 + c;
                pg8::unpack8(*(const v4u*)hp, g2a, g2b); pg8::unpack8(*(const v4u*)(hp + DFF2), g1a, g1b);
                pg8::unpack8(*(const v4u*)(hp + DFF), v2a, v2b); pg8::unpack8(*(const v4u*)(hp + DFF2 + DFF), v1a, v1b); }
            bf16* up = U + (size_t)row0 * DFF2 + c;
#pragma unroll 2
            for (int r = 0; r < 32; ++r) {
                f32x4 g0a, g0b, v0a, v0b; pg8::unpack8(*(const v4u*)(up + (size_t)r * DFF2), g0a, g0b); pg8::unpack8(*(const v4u*)(up + (size_t)r * DFF2 + DFF), v0a, v0b);
                f32x4 oa, ob;
#pragma unroll
                for (int i = 0; i < 4; ++i) {
                    const float ga = bg[i] + wg[2][i] * g0a[i] + wg[1][i] * g1a[i] + wg[0][i] * g2a[i];
                    const float va = bvv[i] + wv[2][i] * v0a[i] + wv[1][i] * v1a[i] + wv[0][i] * v2a[i];
                    const float gb = bg[4 + i] + wg[2][4 + i] * g0b[i] + wg[1][4 + i] * g1b[i] + wg[0][4 + i] * g2b[i];
                    const float vb = bvv[4 + i] + wv[2][4 + i] * v0b[i] + wv[1][4 + i] * v1b[i] + wv[0][4 + i] * v2b[i];
                    oa[i] = ga * pg8::sigmoidf_(ga) * va; ob[i] = gb * pg8::sigmoidf_(gb) * vb; }
                *(v4u*)(up + (size_t)r * DFF2) = pg8::pack8(oa, ob);
                g2a = g1a; g2b = g1b; g1a = g0a; g1b = g0b; v2a = v1a; v2b = v1b; v1a = v0a; v1b = v0b;
            }
        }
    }
    GRID_BAR();
    DBG_DUMP(7);

    if (PHMASK & (1 << 8)) {
        PHASE_PTRS();
        pg8::Gemm g{U, 0, Bt6, 0, DFF2, DFF}; pg8::StaticOrder S; S.init(T, DM, G, bx);
        pg8::EpiDown E{out, ssq_h2};
        pg8::gemm_phase<pg8::EpiDown, pg8::StaticOrder, true, true>(ldsl + RING_OFF, g, S, E);
    }
    GRID_BAR();
    DBG_DUMP(8);

    if (PHMASK & (1 << 9)) {
        PHASE_PTRS();
        const bool bad = (__hip_atomic_load(ctl + CW_BAR + XB_TMO, RLX_AGENT) != 0u);
        for (int m = gw; m < T; m += NGW) {
            GAS f32x4* xr = (GAS f32x4*)(out + (size_t)m * DM) + lane; const GAS f32x4* gr = (const GAS f32x4*)norm_final_g + lane;
            const float rinv = 1.0f / sqrtf(ssq_h2[m] * (1.f / DM) + EPS);
#pragma unroll
            for (int j = 0; j < 4; ++j) { f32x4 v = xr[64 * j]; const f32x4 gg = gr[64 * j]; v = v * rinv * gg; if (bad) v = (f32x4){__builtin_nanf(""), __builtin_nanf(""), __builtin_nanf(""), __builtin_nanf("")}; xr[64 * j] = v; }
        }
    }
}

extern "C" void kernel_launch(void* const* d_in, const int* in_sizes, int n_in, void* d_out, int out_size, void* d_ws, size_t ws_size, hipStream_t stream) {
    static int grid = 0;
    if (grid == 0) {
        if (n_in != 18 || in_sizes[0] != T * DM || out_size != T * DM || ws_size < WS_END) {
            fprintf(stderr, "kernel_launch: shape/workspace mismatch (n_in %d, in0 %d, out %d, ws %zu need %zu); nothing launched\n", n_in, n_in > 0 ? in_sizes[0] : -1, out_size, ws_size, (size_t)WS_END); grid = -1; return; }
        int dev = 0, cus = 0, per_cu = 0;
        if (hipGetDevice(&dev) != hipSuccess || hipDeviceGetAttribute(&cus, hipDeviceAttributeMultiprocessorCount, dev) != hipSuccess) { fprintf(stderr, "kernel_launch: device query failed\n"); grid = -1; return; }
        if (hipFuncSetAttribute((const void*)hybrid_fwd, hipFuncAttributeMaxDynamicSharedMemorySize, LDS_BYTES) != hipSuccess) { fprintf(stderr, "kernel_launch: hipFuncSetAttribute failed\n"); grid = -1; return; }
        if (hipOccupancyMaxActiveBlocksPerMultiprocessor(&per_cu, (const void*)hybrid_fwd, NWAVES * 64, LDS_BYTES) != hipSuccess || per_cu < 1)
            fprintf(stderr, "kernel_launch: note: occupancy query reports %d workgroups per CU\n", per_cu);
        (void)hipGetLastError();
        grid = cus;
    }
    if (grid < 0) return;
    if (hipMemsetAsync((char*)d_ws + WS_CTL, 0, CTL_ZERO_BYTES, stream) != hipSuccess) { fprintf(stderr, "kernel_launch: memset failed\n"); return; }
    KArgs a{};
    for (int i = 0; i < 18; ++i) a.in[i] = (const float*)d_in[i];
    a.out = (float*)d_out; a.ws = (unsigned char*)d_ws;
    hipLaunchKernelGGL(hybrid_fwd, dim3(grid), dim3(NWAVES * 64), LDS_BYTES, stream, a);
    const hipError_t le = hipPeekAtLastError();
    if (le != hipSuccess) fprintf(stderr, "kernel_launch: launch failed: %s\n", hipGetErrorName(le));
}
```
